# Optimizing an MI355X kernel written in HIP

```python
import math
import jax, jax.numpy as jnp
from jax import lax
import numpy as np

D_MODEL = 2048
BATCH = 8
SEQ = 2048
DEPTH = 2

N_A_LAYERS = DEPTH // 2
N_B_LAYERS = DEPTH - N_A_LAYERS
SSM_GROUP = 16
SSM_GROUPS = D_MODEL // SSM_GROUP
SSM_STATE = 64
SCAN_CHUNK = 128
DT_MIN = 1e-3
DT_MAX = 1e-1
HEAD_DIM = 128
N_HEADS = D_MODEL // (2 * HEAD_DIM)
D_FF = 4 * D_MODEL
ROPE_THETA = 10000.0
Q_BLOCK = 128
EPS = 1e-6
LAMBDA_STD = 0.1

kernel_name = 's5_diffattn_yoco_hybrid'


def rms_norm(x, g):
    xf = x.astype(jnp.float32)
    y = xf * lax.rsqrt(jnp.mean(xf * xf, axis=-1, keepdims=True) + EPS)
    return (y * g.astype(jnp.float32)).astype(x.dtype)


def rope_tables(L):
    pos = jnp.arange(L, dtype=jnp.float32)
    inv_freq = 1.0 / (ROPE_THETA ** (jnp.arange(0, HEAD_DIM, 2, dtype=jnp.float32) / HEAD_DIM))
    ang = pos[:, None] * inv_freq[None, :]
    emb = jnp.concatenate([ang, ang], axis=-1)
    return jnp.cos(emb)[:, None, :], jnp.sin(emb)[:, None, :]


def apply_rope(t, cos, sin):
    tf = t.astype(jnp.float32)
    t1, t2 = jnp.split(tf, 2, axis=-1)
    rot = jnp.concatenate([-t2, t1], axis=-1)
    return (tf * cos + rot * sin).astype(t.dtype)


def _cmul(ar, ai, br, bi):
    return ar * br - ai * bi, ar * bi + ai * br


def _scan_combine(e1, e2):
    a1r, a1i, b1r, b1i = e1
    a2r, a2i, b2r, b2i = e2
    ar, ai = _cmul(a2r, a2i, a1r, a1i)
    br, bi = _cmul(a2r, a2i, b1r, b1i)
    return ar, ai, br + b2r, bi + b2i


def s5_mixer(x, w_in, a_re, a_im, log_dt, b_re, b_im, c_re, c_im, d_skip, w_glu):
    f32 = jnp.float32
    Bsz, L, _ = x.shape
    u = (x @ w_in).astype(f32).reshape(Bsz, L, SSM_GROUPS, SSM_GROUP)
    step = jnp.exp(log_dt.astype(f32))[:, None]
    lam_re = jnp.minimum(a_re.astype(f32), -1e-4)
    lam_im = a_im.astype(f32)
    mag = jnp.exp(step * lam_re)
    abar_re = mag * jnp.cos(step * lam_im)
    abar_im = mag * jnp.sin(step * lam_im)
    den = lam_re * lam_re + lam_im * lam_im
    nr = abar_re - 1.0
    ni = abar_im
    coef_re = (nr * lam_re + ni * lam_im) / den
    coef_im = (ni * lam_re - nr * lam_im) / den
    bbar_re, bbar_im = _cmul(coef_re[..., None], coef_im[..., None], b_re.astype(f32), b_im.astype(f32))
    c_r = c_re.astype(f32)
    c_i = c_im.astype(f32)

    n_chunks = L // SCAN_CHUNK
    u_chunks = u.reshape(Bsz, n_chunks, SCAN_CHUNK, SSM_GROUPS, SSM_GROUP).transpose(1, 0, 2, 3, 4)

    def chunk_step(carry, u_c):
        s_re, s_im = carry
        bu_re = jnp.einsum('btgp,gnp->btgn', u_c, bbar_re)
        bu_im = jnp.einsum('btgp,gnp->btgn', u_c, bbar_im)
        a_r = jnp.broadcast_to(abar_re, bu_re.shape)
        a_i = jnp.broadcast_to(abar_im, bu_re.shape)
        acum_re, acum_im, h_re, h_im = lax.associative_scan(
            _scan_combine, (a_r, a_i, bu_re, bu_im), axis=1)
        cr, ci = _cmul(acum_re, acum_im, s_re[:, None], s_im[:, None])
        st_re = h_re + cr
        st_im = h_im + ci
        y = jnp.einsum('btgn,gpn->btgp', st_re, c_r) - jnp.einsum('btgn,gpn->btgp', st_im, c_i)
        return (st_re[:, -1], st_im[:, -1]), y

    init = (jnp.zeros((Bsz, SSM_GROUPS, SSM_STATE), f32), jnp.zeros((Bsz, SSM_GROUPS, SSM_STATE), f32))
    _, ys = lax.scan(chunk_step, init, u_chunks)
    y = ys.transpose(1, 0, 2, 3, 4).reshape(Bsz, L, D_MODEL)
    y = y + d_skip.astype(f32) * u.reshape(Bsz, L, D_MODEL)
    z = jax.nn.gelu(y).astype(x.dtype)
    val, gate = jnp.split(z @ w_glu, 2, axis=-1)
    return val * jax.nn.sigmoid(gate)


def shared_kv(h, g_kv, w_kv, cos, sin):
    Bsz, L, _ = h.shape
    kv = rms_norm(h, g_kv) @ w_kv
    k, v = jnp.split(kv, 2, axis=-1)
    k = k.reshape(Bsz, L, N_HEADS, 2, HEAD_DIM)
    k1 = apply_rope(k[..., 0, :], cos, sin)
    k2 = apply_rope(k[..., 1, :], cos, sin)
    v = v.reshape(Bsz, L, N_HEADS, 2 * HEAD_DIM)
    return k1, k2, v


def diff_attention(x, w_q, lq1, lk1, lq2, lk2, g_sub, w_o, k1, k2, v, cos, sin, lambda_init):
    f32 = jnp.float32
    Bsz, L, _ = x.shape
    scale = HEAD_DIM ** -0.5
    q = (x @ w_q).reshape(Bsz, L, N_HEADS, 2, HEAD_DIM)
    q1 = apply_rope(q[..., 0, :], cos, sin) * scale
    q2 = apply_rope(q[..., 1, :], cos, sin) * scale
    lam = (jnp.exp(jnp.sum(lq1.astype(f32) * lk1.astype(f32)))
           - jnp.exp(jnp.sum(lq2.astype(f32) * lk2.astype(f32))) + lambda_init)

    outs = []
    for i in range(L // Q_BLOCK):
        s0, e = i * Q_BLOCK, (i + 1) * Q_BLOCK
        causal = jnp.arange(e)[None, :] <= (s0 + jnp.arange(Q_BLOCK))[:, None]

        def probs(qb, kp):
            sc = jnp.einsum('bqhd,bkhd->bhqk', qb, kp).astype(f32)
            sc = jnp.where(causal, sc, -jnp.inf)
            return jax.nn.softmax(sc, axis=-1)

        p = probs(q1[:, s0:e], k1[:, :e]) - lam * probs(q2[:, s0:e], k2[:, :e])
        outs.append(jnp.einsum('bhqk,bkhe->bqhe', p.astype(v.dtype), v[:, :e]))
    o = jnp.concatenate(outs, axis=1)
    o = rms_norm(o, g_sub) * (1.0 - lambda_init)
    return o.reshape(Bsz, L, D_MODEL) @ w_o


def sq_relu_mlp(x, w_up, w_down):
    return jnp.square(jax.nn.relu(x @ w_up)) @ w_down


def setup_inputs(seed: int = 0) -> dict:
    key = jax.random.key(seed)
    ks = jax.random.split(key, 32)
    f32 = jnp.float32
    D, G, N, P = D_MODEL, SSM_GROUPS, SSM_STATE, SSM_GROUP

    def nrm(k, shape, std):
        return jax.random.normal(k, shape, f32) * std

    def gain(k, shape):
        return 1.0 + 0.02 * jax.random.normal(k, shape, f32)

    n_idx = jnp.arange(N, dtype=f32)
    return {
        'x': jax.random.normal(ks[0], (BATCH, SEQ, D), f32),
        'mix_pre_g': gain(ks[1], (DEPTH, D)),
        'mix_post_g': gain(ks[2], (DEPTH, D)),
        'mlp_pre_g': gain(ks[3], (DEPTH, D)),
        'mlp_post_g': gain(ks[4], (DEPTH, D)),
        'ssm_w_in': nrm(ks[5], (N_A_LAYERS, D, D), D ** -0.5),
        'ssm_a_re': -0.5 + 0.01 * jax.random.normal(ks[6], (N_A_LAYERS, G, N), f32),
        'ssm_a_im': math.pi * n_idx + 0.01 * jax.random.normal(ks[7], (N_A_LAYERS, G, N), f32),
        'ssm_log_dt': jax.random.uniform(ks[8], (N_A_LAYERS, G), f32, math.log(DT_MIN), math.log(DT_MAX)),
        'ssm_b_re': nrm(ks[9], (N_A_LAYERS, G, N, P), (0.5 / P) ** 0.5),
        'ssm_b_im': nrm(ks[10], (N_A_LAYERS, G, N, P), (0.5 / P) ** 0.5),
        'ssm_c_re': nrm(ks[11], (N_A_LAYERS, G, P, N), (0.5 / N) ** 0.5),
        'ssm_c_im': nrm(ks[12], (N_A_LAYERS, G, P, N), (0.5 / N) ** 0.5),
        'ssm_d': nrm(ks[13], (N_A_LAYERS, D), 1.0),
        'ssm_w_glu': nrm(ks[14], (N_A_LAYERS, D, 2 * D), D ** -0.5),
        'kv_norm_g': gain(ks[15], (D,)),
        'w_kv': nrm(ks[16], (D, 2 * D), D ** -0.5),
        'attn_w_q': nrm(ks[17], (N_B_LAYERS, D, D), D ** -0.5),
        'lam_q1': nrm(ks[18], (N_B_LAYERS, HEAD_DIM), LAMBDA_STD),
        'lam_k1': nrm(ks[19], (N_B_LAYERS, HEAD_DIM), LAMBDA_STD),
        'lam_q2': nrm(ks[20], (N_B_LAYERS, HEAD_DIM), LAMBDA_STD),
        'lam_k2': nrm(ks[21], (N_B_LAYERS, HEAD_DIM), LAMBDA_STD),
        'attn_subln_g': gain(ks[22], (N_B_LAYERS, 2 * HEAD_DIM)),
        'attn_w_o': nrm(ks[23], (N_B_LAYERS, D, D), D ** -0.5),
        'mlp_w_up': nrm(ks[24], (DEPTH, D, D_FF), D ** -0.5),
        'mlp_w_down': nrm(ks[25], (DEPTH, D_FF, D), D_FF ** -0.5),
    }


def reference(x, mix_pre_g, mix_post_g, mlp_pre_g, mlp_post_g,
              ssm_w_in, ssm_a_re, ssm_a_im, ssm_log_dt, ssm_b_re, ssm_b_im, ssm_c_re, ssm_c_im,
              ssm_d, ssm_w_glu, kv_norm_g, w_kv,
              attn_w_q, lam_q1, lam_k1, lam_q2, lam_k2, attn_subln_g, attn_w_o,
              mlp_w_up, mlp_w_down):
    L = x.shape[1]
    cos, sin = rope_tables(L)
    h = x
    k1 = k2 = v = None
    for l in range(DEPTH):
        hn = rms_norm(h, mix_pre_g[l])
        if l < N_A_LAYERS:
            a = l
            mix = s5_mixer(hn, ssm_w_in[a], ssm_a_re[a], ssm_a_im[a], ssm_log_dt[a],
                           ssm_b_re[a], ssm_b_im[a], ssm_c_re[a], ssm_c_im[a], ssm_d[a], ssm_w_glu[a])
        else:
            b = l - N_A_LAYERS
            lambda_init = 0.8 - 0.6 * math.exp(-0.3 * l)
            mix = diff_attention(hn, attn_w_q[b], lam_q1[b], lam_k1[b], lam_q2[b], lam_k2[b],
                                 attn_subln_g[b], attn_w_o[b], k1, k2, v, cos, sin, lambda_init)
        h = h + rms_norm(mix, mix_post_g[l])
        ff = sq_relu_mlp(rms_norm(h, mlp_pre_g[l]), mlp_w_up[l], mlp_w_down[l])
        h = h + rms_norm(ff, mlp_post_g[l])
        if l == N_A_LAYERS - 1:
            k1, k2, v = shared_kv(h, kv_norm_g, w_kv, cos, sin)
    return h
```

```cpp
#include <hip/hip_runtime.h>
#include <hip/hip_cooperative_groups.h>
#include <cstdio>
#include <cstdint>
namespace cg = cooperative_groups;
#ifndef STOP_STAGE
#define STOP_STAGE 0
#endif
namespace pg8 {
#define PG8_LAS __attribute__((address_space(3)))
typedef unsigned short bf16_t;
typedef short bf16x8 __attribute__((ext_vector_type(8)));
typedef float f32x4 __attribute__((ext_vector_type(4)));
typedef unsigned u32x4 __attribute__((ext_vector_type(4)));
constexpr int BM = 256, BK = 64, HALF = 128, HTB = HALF * BK * 2  , STAGE_BYTES = 8 * HTB, NXCD = 8, WGM = 4;

__host__ __device__ __forceinline__ int lds_byte(int r, int c) { const int st = (r >> 4) * 2 + (c >> 5), rr = r & 15, cc = c & 31, ob = rr * 64 + cc * 2; return st * 1024 + (ob ^ (((ob >> 9) & 1) << 5)); }
__host__ __device__ __forceinline__ void stage_rc(int b, int& R, int& C) { const int st = b / 1024, sb = b % 1024, swz = sb ^ (((sb >> 9) & 1) << 5); R = (st >> 1) * 16 + swz / 64; C = (st & 1) * 32 + (swz % 64) / 2; }
__host__ __device__ __forceinline__ int perm32(int rho) { const int n = rho >> 4, i = rho & 15; return 8 * (i >> 2) + 4 * n + (i & 3); }

struct Unit { int pm, pn; };
struct Gemm { const bf16_t* A; const bf16_t* Bt; int M, N, K; };

struct StaticOrder {
    int nM, nN, nwg, G, c;
    __host__ __device__ void init(int M, int N, int G_, int c_) { nM = M / BM; nN = N / BM; nwg = nM * nN; G = G_; c = c_; }
    __host__ __device__ bool next(int i, Unit& u) const {
        const long L = (long)i * G + c; if (L >= nwg) return false;
        int wgid = (int)L; { const int q = nwg / NXCD, r = nwg % NXCD, xcd = wgid % NXCD, off = wgid / NXCD; wgid = (xcd < r ? xcd * (q + 1) : r * (q + 1) + (xcd - r) * q) + off; }
        const int nig = WGM * nN, gid = wgid / nig, fm = gid * WGM, gsz = (nM - fm) < WGM ? (nM - fm) : WGM;
        u.pm = fm + ((wgid % nig) % gsz); u.pn = (wgid % nig) / gsz; return true;
    }
    __device__ __forceinline__ void a_ready(const Unit&) const {}
    __device__ __forceinline__ void done(const Unit&) const {}
};

__device__ __forceinline__ unsigned cvt_pk_bf16(float lo, float hi) { unsigned r; asm volatile("v_cvt_pk_bf16_f32 %0, %1, %2" : "=v"(r) : "v"(lo), "v"(hi)); return r; }
template <class Epi, class Sched, bool ALIGN_EPI = false, bool SP2 = false>
__device__ __forceinline__ void gemm_phase(PG8_LAS unsigned char* lds, const Gemm g, const Sched& S, const Epi& E) {
    const int tid = threadIdx.x, wid = __builtin_amdgcn_readfirstlane(tid >> 6), lane = tid & 63, wr = wid >> 2, wc = wid & 3, fr = lane & 15, fq = lane >> 4;
    const int K = g.K, nt = K / BK;
    unsigned voffA[2], voffB[2];
#pragma unroll
    for (int i = 0; i < 2; ++i) { int R, C; stage_rc(tid * 16 + i * 8192, R, C); const int Rb = Epi::PERM ? ((R & ~31) + perm32(R & 31)) : R;
        voffA[i] = (unsigned)(R * K + C) * 2u; voffB[i] = (unsigned)(Rb * K + C) * 2u; }
    const size_t kstep = (size_t)(BK * 2);
    const size_t hstep = (size_t)HALF * K * 2;
    const size_t tstep = 2 * hstep;
    const unsigned ldsw = (unsigned)wid * 1024u;
    const int aoff = lds_byte(wr * 64 + fr, fq * 8), boff = lds_byte(wc * 32 + fr, fq * 8);
#define PG8_SA(b, h) (((b) * 2 + (h)) * HTB)
#define PG8_SB(b, h) ((4 + (b) * 2 + (h)) * HTB)
#define PG8_STAGE(bufoff, gbase, voff) do { _Pragma("unroll") for (int _i = 0; _i < 2; ++_i) \
        __builtin_amdgcn_global_load_lds((const unsigned*)((const char*)(gbase) + (voff)[_i]), (PG8_LAS unsigned*)(lds + (bufoff) + ldsw + _i * 8192), 16, 0, 0); } while (0)
#define PG8_LDA(dst, b, h) do { _Pragma("unroll") for (int m = 0; m < 4; ++m) _Pragma("unroll") for (int k = 0; k < 2; ++k) dst[m][k] = *(const PG8_LAS bf16x8*)(lds + PG8_SA(b, h) + aoff + m * 2048 + k * 1024); } while (0)
#define PG8_LDB(dst, b, h) do { _Pragma("unroll") for (int n = 0; n < 2; ++n) _Pragma("unroll") for (int k = 0; k < 2; ++k) dst[n][k] = *(const PG8_LAS bf16x8*)(lds + PG8_SB(b, h) + boff + n * 2048 + k * 1024); } while (0)
#define PG8_MMA(ai, bj, At, Bt) do { __builtin_amdgcn_s_setprio(1); _Pragma("unroll") for (int m = 0; m < 4; ++m) _Pragma("unroll") for (int n = 0; n < 2; ++n) _Pragma("unroll") for (int k = 0; k < 2; ++k) \
        acc[ai][bj][m][n] = __builtin_amdgcn_mfma_f32_16x16x32_bf16(Bt[n][k], At[m][k], acc[ai][bj][m][n], 0, 0, 0); __builtin_amdgcn_s_setprio(0); } while (0)
#define PG8_WAIT_V(n) asm volatile("s_waitcnt vmcnt(" #n ")" ::: "memory")
#define PG8_WAIT_L(n) asm volatile("s_waitcnt lgkmcnt(" #n ")" ::: "memory")
#define PG8_BAR __builtin_amdgcn_s_barrier()
#define PG8_SCHED __builtin_amdgcn_sched_barrier(0)
    Unit cur, nxt; int ui = 0;
    if (!S.next(0, cur)) return;
    f32x4 acc[2][2][4][2];
#pragma unroll
    for (int a = 0; a < 2; ++a)
#pragma unroll
        for (int b = 0; b < 2; ++b)
#pragma unroll
            for (int m = 0; m < 4; ++m)
#pragma unroll
                for (int n = 0; n < 2; ++n) acc[a][b][m][n] = (f32x4){0.f, 0.f, 0.f, 0.f};
    bf16x8 At[4][2], B0[2][2], B1[2][2];
    const char* cA = (const char*)g.A + (size_t)cur.pm * tstep; const char* cB = (const char*)g.Bt + (size_t)cur.pn * tstep;
    S.a_ready(cur);
    if constexpr (SP2) {
        PG8_STAGE(PG8_SB(0, 0), cB, voffB); PG8_STAGE(PG8_SB(0, 1), cB + hstep, voffB); PG8_STAGE(PG8_SA(0, 0), cA, voffA); PG8_STAGE(PG8_SA(0, 1), cA + hstep, voffA);
        if (wr == 1) PG8_BAR;
        PG8_WAIT_V(2); PG8_BAR;
        PG8_STAGE(PG8_SB(1, 0), cB + kstep, voffB); PG8_STAGE(PG8_SA(1, 0), cA + kstep, voffA); PG8_STAGE(PG8_SB(1, 1), cB + hstep + kstep, voffB);
        PG8_WAIT_V(6); PG8_BAR;
    } else {
        PG8_STAGE(PG8_SB(0, 0), cB, voffB); PG8_STAGE(PG8_SA(0, 0), cA, voffA); PG8_STAGE(PG8_SB(0, 1), cB + hstep, voffB); PG8_STAGE(PG8_SA(0, 1), cA + hstep, voffA);
        if (wr == 1) PG8_BAR;
        PG8_WAIT_V(4); PG8_BAR;
        PG8_STAGE(PG8_SB(1, 0), cB + kstep, voffB); PG8_STAGE(PG8_SA(1, 0), cA + kstep, voffA); PG8_STAGE(PG8_SB(1, 1), cB + hstep + kstep, voffB);
        PG8_WAIT_V(6); PG8_BAR;
    }
    for (;;) {
        const bool has_next = S.next(ui + 1, nxt);
        const char* nA = has_next ? (const char*)g.A + (size_t)nxt.pm * tstep : cA; const char* nB = has_next ? (const char*)g.Bt + (size_t)nxt.pn * tstep : cB;
        for (int t = 0; t < nt; t += 2) {
            const bool last = (t == nt - 2);
            const char* a1 = cA + (size_t)(t + 1) * kstep;
            const char* a2 = last ? nA : cA + (size_t)(t + 2) * kstep; const char* b2 = last ? nB : cB + (size_t)(t + 2) * kstep;
            const char* a3 = a2 + kstep; const char* b3 = b2 + kstep;
            if (last && has_next) S.a_ready(nxt);
            if constexpr (SP2) {
            PG8_LDB(B0, 0, 0); PG8_LDB(B1, 0, 1); PG8_SCHED; PG8_LDA(At, 0, 0); PG8_STAGE(PG8_SA(1, 1), a1 + hstep, voffA);
            PG8_WAIT_V(8); PG8_WAIT_L(0); PG8_BAR; PG8_MMA(0, 0, At, B0); PG8_MMA(0, 1, At, B1); PG8_BAR; PG8_SCHED;
            PG8_LDA(At, 0, 1); PG8_STAGE(PG8_SB(0, 0), b2, voffB); PG8_STAGE(PG8_SB(0, 1), b2 + hstep, voffB); PG8_STAGE(PG8_SA(0, 0), a2, voffA);
            PG8_WAIT_V(8); PG8_WAIT_L(0); PG8_BAR; PG8_MMA(1, 0, At, B0); PG8_MMA(1, 1, At, B1); PG8_BAR; PG8_SCHED;
            PG8_LDB(B0, 1, 0); PG8_LDB(B1, 1, 1); PG8_SCHED; PG8_LDA(At, 1, 0); PG8_STAGE(PG8_SA(0, 1), a2 + hstep, voffA);
            PG8_WAIT_V(8); PG8_WAIT_L(0); PG8_BAR; PG8_MMA(0, 0, At, B0); PG8_MMA(0, 1, At, B1); PG8_BAR; PG8_SCHED;
            PG8_LDA(At, 1, 1); PG8_STAGE(PG8_SB(1, 0), b3, voffB); PG8_STAGE(PG8_SB(1, 1), b3 + hstep, voffB); PG8_STAGE(PG8_SA(1, 0), a3, voffA);
            PG8_WAIT_V(8); PG8_WAIT_L(0); PG8_BAR; PG8_MMA(1, 0, At, B0); PG8_MMA(1, 1, At, B1); PG8_BAR; PG8_SCHED;
            } else {
            PG8_LDB(B0, 0, 0); PG8_SCHED; PG8_LDA(At, 0, 0); PG8_STAGE(PG8_SA(1, 1), a1 + hstep, voffA);
            PG8_WAIT_L(8); PG8_BAR; PG8_WAIT_L(0); PG8_MMA(0, 0, At, B0); PG8_BAR; PG8_SCHED;
            PG8_LDB(B1, 0, 1); PG8_STAGE(PG8_SB(0, 0), b2, voffB);
            PG8_BAR; PG8_WAIT_L(0); PG8_MMA(0, 1, At, B1); PG8_BAR;
            PG8_LDA(At, 0, 1); PG8_STAGE(PG8_SA(0, 0), a2, voffA);
            PG8_BAR; PG8_WAIT_L(0); PG8_MMA(1, 0, At, B0); PG8_BAR; PG8_SCHED;
            PG8_STAGE(PG8_SB(0, 1), b2 + hstep, voffB);
            PG8_WAIT_V(6); PG8_BAR; PG8_MMA(1, 1, At, B1); PG8_BAR;
            PG8_LDB(B0, 1, 0); PG8_SCHED; PG8_LDA(At, 1, 0); PG8_STAGE(PG8_SA(0, 1), a2 + hstep, voffA);
            PG8_WAIT_L(8); PG8_BAR; PG8_WAIT_L(0); PG8_MMA(0, 0, At, B0); PG8_BAR; PG8_SCHED;
            PG8_LDB(B1, 1, 1); PG8_STAGE(PG8_SB(1, 0), b3, voffB);
            PG8_BAR; PG8_WAIT_L(0); PG8_MMA(0, 1, At, B1); PG8_BAR;
            PG8_LDA(At, 1, 1); PG8_STAGE(PG8_SA(1, 0), a3, voffA);
            PG8_BAR; PG8_WAIT_L(0); PG8_MMA(1, 0, At, B0); PG8_BAR; PG8_SCHED;
            PG8_STAGE(PG8_SB(1, 1), b3 + hstep, voffB);
            PG8_WAIT_V(6); PG8_BAR; PG8_MMA(1, 1, At, B1); PG8_BAR;
            }
        }
        if constexpr (ALIGN_EPI) { if (wr == 0) PG8_BAR; }
        if constexpr (!Epi::AFTER_DRAIN) { E(acc, cur, wr, wc, fr, fq); S.done(cur); }
        if (!has_next) break;
#pragma unroll
        for (int a = 0; a < 2; ++a)
#pragma unroll
            for (int b = 0; b < 2; ++b)
#pragma unroll
                for (int m = 0; m < 4; ++m)
#pragma unroll
                    for (int n = 0; n < 2; ++n) acc[a][b][m][n] = (f32x4){0.f, 0.f, 0.f, 0.f};
        cur = nxt; cA = nA; cB = nB; ++ui;
        if constexpr (ALIGN_EPI) { if (wr == 1) PG8_BAR; }
    }
    PG8_WAIT_V(0);
    if constexpr (!ALIGN_EPI) { if (wr == 0) PG8_BAR; }
    PG8_BAR;
    if constexpr (Epi::AFTER_DRAIN) { E.fused(acc, cur, wr, wc, fr, fq, lds, wid, lane); S.done(cur); }
#undef PG8_SA
#undef PG8_SB
#undef PG8_STAGE
#undef PG8_LDA
#undef PG8_LDB
#undef PG8_MMA
#undef PG8_WAIT_V
#undef PG8_WAIT_L
#undef PG8_BAR
#undef PG8_SCHED
}
}

#define GAS __attribute__((address_space(1)))
#define LAS __attribute__((address_space(3)))
typedef unsigned short bf16;
typedef unsigned v4u __attribute__((ext_vector_type(4)));
typedef unsigned v2u __attribute__((ext_vector_type(2)));
typedef float f32x4 __attribute__((ext_vector_type(4)));
typedef float f32x16 __attribute__((ext_vector_type(16)));
typedef short bf16x8 __attribute__((ext_vector_type(8)));

constexpr int M = 16384, D = 2048, SEQ = 2048, FF = 8192, NG = 128;
constexpr float EPS = 1e-6f;
constexpr size_t MiB = 1u << 20;
constexpr size_t WS_WIN = 0, WS_WGLU = 8 * MiB, WS_WUP0 = 24 * MiB, WS_WDN0 = 56 * MiB, WS_WQKV = 88 * MiB, WS_WO = 112 * MiB, WS_WUP1 = 120 * MiB, WS_WDN1 = 152 * MiB;
constexpr size_t WS_XN = 184 * MiB, WS_R = 248 * MiB, WS_SMALL = 504 * MiB, WS_END = 512 * MiB;
constexpr size_t R_U = 0, R_Z = 64 * MiB, R_MIX = 128 * MiB, R_MG = 192 * MiB, R_WINM = 208 * MiB, R_WOUTM = 216 * MiB;
constexpr size_t R_Q = 0, R_K = 64 * MiB, R_VT = 128 * MiB, R_O = 192 * MiB, R_MIX1 = 64 * MiB;
constexpr size_t S_ROPE = 1 * MiB, S_A16 = 2 * MiB, S_RSP = 3 * MiB, S_RSTD = 7 * MiB;
constexpr int RING_BYTES = 139264, LDS_BYTES = 143360;

__device__ __forceinline__ unsigned f2bf(float f) { unsigned u = __builtin_bit_cast(unsigned, f); return (u + 0x7fffu + ((u >> 16) & 1u)) >> 16; }
__device__ __forceinline__ unsigned pk2(float lo, float hi) { return pg8::cvt_pk_bf16(lo, hi); }
__device__ __forceinline__ float bf2f(unsigned short b) { return __builtin_bit_cast(float, (unsigned)b << 16); }
__device__ __forceinline__ float wave_sum(float v) {
#pragma unroll
    for (int o = 1; o < 64; o <<= 1) v += __shfl_xor(v, o);
    return v;
}

namespace pg8 {
template <int ACT, bool RS, bool SC = false> struct EpiStore {
    static constexpr bool PERM = true, AFTER_DRAIN = false;
    bf16_t* O; int ldc; float* rsp; const float* rstd;
    __device__ __forceinline__ void operator()(const f32x4 (&acc)[2][2][4][2], const Unit& u, int wr, int wc, int fr, int fq) const {
        const int row0 = u.pm * BM + wr * 64 + fr, col0 = u.pn * BM + wc * 32 + 8 * fq;
#pragma unroll
        for (int ai = 0; ai < 2; ++ai)
#pragma unroll
            for (int m = 0; m < 4; ++m) {
                const int row = row0 + ai * HALF + m * 16;
                bf16_t* rowp = O + (size_t)row * ldc + col0; float ss = 0.f;
#pragma unroll
                for (int bj = 0; bj < 2; ++bj) {
                    f32x4 v0 = acc[ai][bj][m][0], v1 = acc[ai][bj][m][1];
                    if (SC) { const float rsd = rstd[row]; v0 = v0 * rsd; v1 = v1 * rsd; }
                    if (ACT == 1) {
#pragma unroll
                        for (int e = 0; e < 4; ++e) { const float a = fmaxf(v0[e], 0.f), b = fmaxf(v1[e], 0.f); v0[e] = a * a; v1[e] = b * b; }
                    }
                    if (RS) ss += (v0[0] * v0[0] + v0[1] * v0[1]) + (v0[2] * v0[2] + v0[3] * v0[3]) + (v1[0] * v1[0] + v1[1] * v1[1]) + (v1[2] * v1[2] + v1[3] * v1[3]);
                    u32x4 w; w.x = cvt_pk_bf16(v0[0], v0[1]); w.y = cvt_pk_bf16(v0[2], v0[3]); w.z = cvt_pk_bf16(v1[0], v1[1]); w.w = cvt_pk_bf16(v1[2], v1[3]);
                    *(u32x4*)(rowp + bj * HALF) = w;
                }
                if (RS) { ss += __shfl_xor(ss, 16); ss += __shfl_xor(ss, 32); if (fq == 0) rsp[(size_t)row * 64 + u.pn * 4 + wc] = ss; }
            }
    }
};
struct EpiGlu {
    static constexpr bool PERM = true, AFTER_DRAIN = false;
    bf16_t* O; float* rsp;
    __device__ __forceinline__ void operator()(const f32x4 (&acc)[2][2][4][2], const Unit& u, int wr, int wc, int fr, int fq) const {
        const int row0 = u.pm * BM + wr * 64 + fr, col0 = u.pn * HALF + wc * 32 + 8 * fq;
#pragma unroll
        for (int ai = 0; ai < 2; ++ai)
#pragma unroll
            for (int m = 0; m < 4; ++m) {
                const int row = row0 + ai * HALF + m * 16; float ss = 0.f; float o[8];
#pragma unroll
                for (int n = 0; n < 2; ++n)
#pragma unroll
                    for (int e = 0; e < 4; ++e) { const float a = acc[ai][0][m][n][e], g = acc[ai][1][m][n][e]; const float r = a * __builtin_amdgcn_rcpf(1.f + __expf(-g)); o[4 * n + e] = r; ss += r * r; }
                u32x4 w; w.x = cvt_pk_bf16(o[0], o[1]); w.y = cvt_pk_bf16(o[2], o[3]); w.z = cvt_pk_bf16(o[4], o[5]); w.w = cvt_pk_bf16(o[6], o[7]);
                *(u32x4*)(O + (size_t)row * 2048 + col0) = w;
                ss += __shfl_xor(ss, 16); ss += __shfl_xor(ss, 32); if (fq == 0) rsp[(size_t)row * 64 + u.pn * 4 + wc] = ss;
            }
    }
};
struct EpiQKV {
    static constexpr bool PERM = true, AFTER_DRAIN = false;
    bf16_t *Kb, *VT, *Qb; const float* cosT; const float* sinT; float qscale; const float* rstd;
    __device__ __forceinline__ void operator()(const f32x4 (&acc)[2][2][4][2], const Unit& u, int wr, int wc, int fr, int fq) const {
        const int row0 = u.pm * BM + wr * 64 + fr;
        if (u.pn >= 8 && u.pn < 16) {
            const int h = u.pn - 8; const int op = (fr & 3) + ((fr >> 3) & 1) * 4 + ((fr >> 2) & 1) * 8;
#pragma unroll
            for (int ai = 0; ai < 2; ++ai)
#pragma unroll
                for (int m = 0; m < 4; ++m) {
                    const int row = row0 + ai * HALF + m * 16; const int b = row >> 11, t = row & 2047; const int tp = (t & ~15) + op;
                    bf16_t* base = VT + ((size_t)(b * 8 + h) * 256 + wc * 32 + 8 * fq) * 2048 + tp; const float rsd = rstd[row];
#pragma unroll
                    for (int bj = 0; bj < 2; ++bj)
#pragma unroll
                        for (int n = 0; n < 2; ++n)
#pragma unroll
                            for (int e = 0; e < 4; ++e) { const float v = acc[ai][bj][m][n][e] * rsd; base[(size_t)(bj * HALF + 4 * n + e) * 2048] = (bf16_t)(cvt_pk_bf16(v, v) & 0xffffu); }
                }
        } else {
            const bool isq = u.pn >= 16; bf16_t* basep = isq ? Qb : Kb; const int hp = isq ? u.pn - 16 : u.pn; const float sc = isq ? qscale : 1.f;
#pragma unroll
            for (int ai = 0; ai < 2; ++ai)
#pragma unroll
                for (int m = 0; m < 4; ++m) {
                    const int row = row0 + ai * HALF + m * 16; const int pos = row & 2047; const float rsc = rstd[row] * sc;
                    const f32x4 c4 = *(const f32x4*)(cosT + pos * 64 + wc * 16 + fq * 4), s4 = *(const f32x4*)(sinT + pos * 64 + wc * 16 + fq * 4);
#pragma unroll
                    for (int bj = 0; bj < 2; ++bj) {
                        const f32x4 x1 = acc[ai][bj][m][0], x2 = acc[ai][bj][m][1];
                        const f32x4 o1 = (x1 * c4 - x2 * s4) * rsc, o2 = (x2 * c4 + x1 * s4) * rsc;
                        bf16_t* p = basep + (size_t)row * 2048 + hp * 256 + bj * HALF + wc * 16 + fq * 4;
                        v2u w1, w2; w1.x = cvt_pk_bf16(o1[0], o1[1]); w1.y = cvt_pk_bf16(o1[2], o1[3]); w2.x = cvt_pk_bf16(o2[0], o2[1]); w2.y = cvt_pk_bf16(o2[2], o2[3]);
                        *(v2u*)p = w1; *(v2u*)(p + 64) = w2;
                    }
                }
        }
    }
};
}

struct Frame {
    LAS unsigned char* lds;
    int tid, lane, wave, vcu, G;
    float* out; unsigned char* ws;
};
struct Args { const float* in[26]; float* out; unsigned char* ws; int ph_lo, ph_hi; };

__device__ __forceinline__ int ropeperm(int c) { const int head = c >> 7, d = c & 127, n = d >> 6, rem = d & 63; return head * 128 + 32 * (rem >> 4) + 8 * ((rem >> 2) & 3) + 4 * n + (rem & 3); }
__device__ __forceinline__ int dstrow(int kind, int c) {
    if (kind == 1) { return c < 2048 ? ((c >> 7) * 256 + (c & 127)) : (((c - 2048) >> 7) * 256 + 128 + ((c - 2048) & 127)); }
    if (kind == 2) return ropeperm(c);
    if (kind == 3) return c < 2048 ? ropeperm(c) : c;
    return c;
}
__device__ __forceinline__ void transpose_item(const float* W, int K, int N, bf16* WT, int kind, int row_off, const float* gain, int gmask, float gscale, LAS float* scr, int item, int lane) {
    const int nblk = N / 32, kb = item / nblk, nb = item % nblk, k0 = 64 * kb, n0 = 32 * nb;
    f32x4 v[8]; float gg[8];
#pragma unroll
    for (int i = 0; i < 8; ++i) { const int kk = 8 * i + (lane >> 3); v[i] = *(const f32x4*)(W + (size_t)(k0 + kk) * N + n0 + 4 * (lane & 7)); gg[i] = gain ? gain[(k0 + kk) & gmask] * gscale : 1.f; }
#pragma unroll
    for (int i = 0; i < 8; ++i) { const int kk = 8 * i + (lane >> 3); LAS float* d = scr + kk * 33 + 4 * (lane & 7);
        d[0] = v[i][0] * gg[i]; d[1] = v[i][1] * gg[i]; d[2] = v[i][2] * gg[i]; d[3] = v[i][3] * gg[i]; }
    asm volatile("s_waitcnt lgkmcnt(0)" ::: "memory");
    const int c = lane & 7;
#pragma unroll
    for (int j = 0; j < 4; ++j) { const int n = (lane >> 3) + 8 * j; const LAS float* s = scr + (8 * c) * 33 + n;
        v4u o; o.x = pk2(s[0 * 33], s[1 * 33]); o.y = pk2(s[2 * 33], s[3 * 33]); o.z = pk2(s[4 * 33], s[5 * 33]); o.w = pk2(s[6 * 33], s[7 * 33]);
        *(v4u*)(WT + (size_t)(row_off + dstrow(kind, n0 + n)) * K + k0 + 8 * c) = o; }
    asm volatile("s_waitcnt lgkmcnt(0)" ::: "memory");
}

__device__ __forceinline__ void s5_build(Frame& F, const Args& A, int g, int half) {
    LAS float* T = (LAS float*)F.lds;
    LAS float *AP_re = T, *AP_im = T + 1088, *BB_re = T + 2176, *BB_im = T + 3200, *CR = T + 4224, *CI = T + 5248, *KT = T + 6272;
    const float* a_re = A.in[6]; const float* a_im = A.in[7]; const float* log_dt = A.in[8]; const float* b_re = A.in[9]; const float* b_im = A.in[10]; const float* c_re = A.in[11]; const float* c_im = A.in[12];
    bf16* MG = (bf16*)(F.ws + WS_R + R_MG); bf16* WINM = (bf16*)(F.ws + WS_R + R_WINM); bf16* WOUTM = (bf16*)(F.ws + WS_R + R_WOUTM); float* A16 = (float*)(F.ws + WS_SMALL + S_A16);
    const int tid = F.tid;
    const float step = expf(log_dt[g]);
    __syncthreads();
    for (int e = tid; e < 1088; e += 512) { const int tau = e >> 6, n = e & 63; const float lre = fminf(a_re[g * 64 + n], -1e-4f), lim = a_im[g * 64 + n];
        const float mag = expf((float)tau * (step * lre)), ang = (float)tau * (step * lim); AP_re[e] = mag * cosf(ang); AP_im[e] = mag * sinf(ang); }
    for (int e = tid; e < 1024; e += 512) { CR[e] = c_re[g * 1024 + e]; CI[e] = c_im[g * 1024 + e]; }
    __syncthreads();
    for (int e = tid; e < 1024; e += 512) { const int n = e >> 4; const float lre = fminf(a_re[g * 64 + n], -1e-4f), lim = a_im[g * 64 + n];
        const float den = lre * lre + lim * lim, nr = AP_re[64 + n] - 1.f, ni = AP_im[64 + n];
        const float cr = (nr * lre + ni * lim) / den, ci = (ni * lre - nr * lim) / den; const float br = b_re[g * 1024 + e], bi = b_im[g * 1024 + e];
        BB_re[e] = cr * br - ci * bi; BB_im[e] = cr * bi + ci * br; }
    if (half == 0 && tid < 64) { A16[(g * 64 + tid) * 2] = AP_re[16 * 64 + tid]; A16[(g * 64 + tid) * 2 + 1] = AP_im[16 * 64 + tid]; }
    __syncthreads();
    for (int e2 = tid; e2 < 2048; e2 += 512) { const int tau = e2 >> 7, p = half * 8 + ((e2 >> 4) & 7), q = e2 & 15, e = (tau << 8) + (p << 4) + q; float acc = 0.f;
        for (int n = 0; n < 64; ++n) { const float ar = AP_re[tau * 64 + n], ai = AP_im[tau * 64 + n], br = BB_re[n * 16 + q], bi = BB_im[n * 16 + q];
            const float tr = ar * br - ai * bi, ti = ar * bi + ai * br; acc += CR[p * 64 + n] * tr - CI[p * 64 + n] * ti; }
        KT[e] = acc; }
    __syncthreads();
    for (int c2 = tid; c2 < 4096; c2 += 512) { const int r2 = c2 >> 5, ch = c2 & 31, j = r2 >> 3, p = half * 8 + (r2 & 7), row = j * 16 + p, i = (ch & 31) >> 1, q0 = (ch & 1) * 8; float v[8];
#pragma unroll
        for (int e = 0; e < 8; ++e) v[e] = (i <= j) ? KT[((j - i) << 8) + (p << 4) + q0 + e] : 0.f;
        v4u o; o.x = pk2(v[0], v[1]); o.y = pk2(v[2], v[3]); o.z = pk2(v[4], v[5]); o.w = pk2(v[6], v[7]);
        *(v4u*)(MG + (size_t)g * 65536 + ((((row >> 4) * 8 + ((ch & 31) >> 2)) * 64) + (row & 15) + 16 * (ch & 3)) * 8) = o; }
    for (int c2 = tid; c2 < 2048; c2 += 512) { const int ch = c2 & 31, np = half * 64 + (c2 >> 5), n = np & 63, im = np >> 6, i = (ch & 31) >> 1, q0 = (ch & 1) * 8, tau = 15 - i; float v[8];
        const float ar = AP_re[tau * 64 + n], ai = AP_im[tau * 64 + n];
#pragma unroll
        for (int e = 0; e < 8; ++e) { const float br = BB_re[n * 16 + q0 + e], bi = BB_im[n * 16 + q0 + e]; v[e] = im ? (ar * bi + ai * br) : (ar * br - ai * bi); }
        v4u o; o.x = pk2(v[0], v[1]); o.y = pk2(v[2], v[3]); o.z = pk2(v[4], v[5]); o.w = pk2(v[6], v[7]);
        *(v4u*)(WINM + (size_t)g * 32768 + ((((np >> 4) * 8 + ((ch & 31) >> 2)) * 64) + (np & 15) + 16 * (ch & 3)) * 8) = o; }
    for (int c2 = tid; c2 < 2048; c2 += 512) { const int r2 = c2 >> 4, ch = c2 & 15, j = r2 >> 3, p = half * 8 + (r2 & 7), row = j * 16 + p, n0 = (ch & 15) * 8, im = n0 >> 6, tau = j + 1; float v[8];
#pragma unroll
        for (int e = 0; e < 8; ++e) { const int n = (n0 & 63) + e; const float ar = AP_re[tau * 64 + n], ai = AP_im[tau * 64 + n], cr = CR[p * 64 + n], ci = CI[p * 64 + n]; v[e] = im ? -(cr * ai + ci * ar) : (cr * ar - ci * ai); }
        v4u o; o.x = pk2(v[0], v[1]); o.y = pk2(v[2], v[3]); o.z = pk2(v[4], v[5]); o.w = pk2(v[6], v[7]);
        *(v4u*)(WOUTM + (size_t)g * 32768 + ((((row >> 4) * 4 + ((ch & 15) >> 2)) * 64) + (row & 15) + 16 * (ch & 3)) * 8) = o; }
    __syncthreads();
}

__device__ __forceinline__ void prologue_item(Frame& F, const Args& A, LAS float* scr, int it, float linit) {
    constexpr int I_SQ = 32 * 64, I_GLU = 32 * 128, I_UP = 32 * 256, I_DN = 128 * 64;
        int r = it;
        if (r < I_SQ) { transpose_item(A.in[5], D, D, (bf16*)(F.ws + WS_WIN), 0, 0, A.in[1], 0x7fffffff, 1.f, scr, r, F.lane); return; } r -= I_SQ;
        if (r < I_GLU) { transpose_item(A.in[14], D, 2 * D, (bf16*)(F.ws + WS_WGLU), 1, 0, nullptr, 0, 1.f, scr, r, F.lane); return; } r -= I_GLU;
        if (r < I_UP) { transpose_item(A.in[24], D, FF, (bf16*)(F.ws + WS_WUP0), 0, 0, A.in[3], 0x7fffffff, 1.f, scr, r, F.lane); return; } r -= I_UP;
        if (r < I_UP) { transpose_item(A.in[24] + (size_t)D * FF, D, FF, (bf16*)(F.ws + WS_WUP1), 0, 0, A.in[3] + D, 0x7fffffff, 1.f, scr, r, F.lane); return; } r -= I_UP;
        if (r < I_DN) { transpose_item(A.in[25], FF, D, (bf16*)(F.ws + WS_WDN0), 0, 0, nullptr, 0, 1.f, scr, r, F.lane); return; } r -= I_DN;
        if (r < I_DN) { transpose_item(A.in[25] + (size_t)D * FF, FF, D, (bf16*)(F.ws + WS_WDN1), 0, 0, nullptr, 0, 1.f, scr, r, F.lane); return; } r -= I_DN;
        if (r < I_GLU) { transpose_item(A.in[16], D, 2 * D, (bf16*)(F.ws + WS_WQKV), 3, 0, A.in[15], 0x7fffffff, 1.f, scr, r, F.lane); return; } r -= I_GLU;
        if (r < I_SQ) { transpose_item(A.in[17], D, D, (bf16*)(F.ws + WS_WQKV), 2, 4096, A.in[1] + D, 0x7fffffff, 1.f, scr, r, F.lane); return; } r -= I_SQ;
        transpose_item(A.in[23], D, D, (bf16*)(F.ws + WS_WO), 0, 0, A.in[22], 255, 1.f - linit, scr, r, F.lane);
}
__device__ __forceinline__ void p0_prologue(Frame& F, const Args& A) {
    for (int w = F.vcu; w < 2 * NG; w += F.G) s5_build(F, A, w >> 1, w & 1);
    __syncthreads();
    LAS float* scr = (LAS float*)(F.lds + F.wave * 16384);
    const int gw = F.vcu * 8 + F.wave, NGW = F.G * 8;
    constexpr int I_SQ = 32 * 64, I_GLU = 32 * 128, I_UP = 32 * 256, I_DN = 128 * 64;
    constexpr int NITEMS = I_SQ + I_GLU + 2 * I_UP + 2 * I_DN + I_GLU + 2 * I_SQ;
    const float linit = 0.8f - 0.6f * expf(-0.3f);
    constexpr int NA = 47104;
    for (int it = gw; it < NA; it += NGW) prologue_item(F, A, scr, it, linit);
    if (F.G > NG) { if (F.vcu >= NG) for (int it = NA + gw - NG * 8; it < NITEMS; it += (F.G - NG) * 8) prologue_item(F, A, scr, it, linit); }
    else for (int it = NA + gw; it < NITEMS; it += NGW) prologue_item(F, A, scr, it, linit);
    { const float* x = A.in[0]; bf16* XN = (bf16*)(F.ws + WS_XN); float* rstd = (float*)(F.ws + WS_SMALL + S_RSTD);
      for (int m = gw; m < M; m += NGW) { const f32x4* xr = (const f32x4*)(x + (size_t)m * D) + F.lane; f32x4 v[8]; float ss = 0.f;
#pragma unroll
          for (int j = 0; j < 8; ++j) { v[j] = xr[64 * j]; ss += (v[j].x * v[j].x + v[j].y * v[j].y) + (v[j].z * v[j].z + v[j].w * v[j].w); }
          const float r = rsqrtf(wave_sum(ss) * (1.f / D) + EPS); if (F.lane == 0) rstd[m] = r;
          v2u* o = (v2u*)(XN + (size_t)m * D) + F.lane;
#pragma unroll
          for (int j = 0; j < 8; ++j) { v2u w; w.x = pk2(v[j].x, v[j].y); w.y = pk2(v[j].z, v[j].w); o[64 * j] = w; } } }
    { float* cosT = (float*)(F.ws + WS_SMALL + S_ROPE); float* sinT = cosT + 2048 * 64;
      for (int e = (F.vcu * 512 + F.tid); e < 2048 * 64; e += F.G * 512) { const int pos = e >> 6, i = e & 63;
          const float inv = 1.0f / powf(10000.0f, (float)i * (1.0f / 64.0f)); const float ang = (float)pos * inv; cosT[e] = cosf(ang); sinT[e] = sinf(ang); } }
}

template <bool IN_F32> __device__ __forceinline__ void rowpass(Frame& F, const void* hin_, const bf16* y, const float* rsp, int nslots, const float* gpost, bf16* hout, float* rstd, float* fout) {
    const int gw = F.vcu * 8 + F.wave, NGW = F.G * 8;
    for (int m = gw; m < M; m += NGW) {
        float part = (F.lane < nslots) ? rsp[(size_t)m * 64 + F.lane] : 0.f; part = wave_sum(part);
        const float ry = rsqrtf(part * (1.f / D) + EPS);
        f32x4 hv[8]; float ss = 0.f;
#pragma unroll
        for (int j = 0; j < 8; ++j) { const int idx = j * 256 + F.lane * 4; f32x4 h4;
            if (IN_F32) h4 = *(const f32x4*)((const float*)hin_ + (size_t)m * D + idx);
            else { const v2u hb = *(const v2u*)((const bf16*)hin_ + (size_t)m * D + idx); h4.x = __builtin_bit_cast(float, hb.x << 16); h4.y = __builtin_bit_cast(float, hb.x & 0xffff0000u); h4.z = __builtin_bit_cast(float, hb.y << 16); h4.w = __builtin_bit_cast(float, hb.y & 0xffff0000u); }
            const v2u yb = *(const v2u*)(y + (size_t)m * D + idx); const f32x4 g4 = *(const f32x4*)(gpost + idx);
            f32x4 yv; yv.x = __builtin_bit_cast(float, yb.x << 16); yv.y = __builtin_bit_cast(float, yb.x & 0xffff0000u); yv.z = __builtin_bit_cast(float, yb.y << 16); yv.w = __builtin_bit_cast(float, yb.y & 0xffff0000u);
            hv[j] = h4 + yv * ry * g4; ss += (hv[j].x * hv[j].x + hv[j].y * hv[j].y) + (hv[j].z * hv[j].z + hv[j].w * hv[j].w); }
        if (fout) {
#pragma unroll
            for (int j = 0; j < 8; ++j) *(f32x4*)(fout + (size_t)m * D + j * 256 + F.lane * 4) = hv[j];
        } else {
            const float rh = rsqrtf(wave_sum(ss) * (1.f / D) + EPS); if (F.lane == 0) rstd[m] = rh;
#pragma unroll
            for (int j = 0; j < 8; ++j) { v2u w; w.x = pk2(hv[j].x, hv[j].y); w.y = pk2(hv[j].z, hv[j].w); *(v2u*)(hout + (size_t)m * D + j * 256 + F.lane * 4) = w; }
        }
    }
}

#define MFMA16(a, b, c) __builtin_amdgcn_mfma_f32_16x16x32_bf16((a), (b), (c), 0, 0, 0)
#define MFMA32(a, b, c) __builtin_amdgcn_mfma_f32_32x32x16_bf16((a), (b), (c), 0, 0, 0)
__device__ __forceinline__ float gelu_tanh(float y) { return y * __builtin_amdgcn_rcpf(1.f + __expf(-1.5957691216057308f * (y + 0.044715f * y * y * y))); }
__device__ __forceinline__ void s5_unit(Frame& F, const float* dskip, int b, int g) {
    LAS unsigned char* L = F.lds;
    LAS float* VL = (LAS float*)(F.lds + 65536);
    LAS bf16* SP = (LAS bf16*)F.lds;
    const bf16* U = (const bf16*)(F.ws + WS_R + R_U); bf16* Z = (bf16*)(F.ws + WS_R + R_Z);
    const bf16* MG = (const bf16*)(F.ws + WS_R + R_MG) + (size_t)g * 65536; const bf16* WINM = (const bf16*)(F.ws + WS_R + R_WINM) + (size_t)g * 32768; const bf16* WOUTM = (const bf16*)(F.ws + WS_R + R_WOUTM) + (size_t)g * 32768;
    const float* A16 = (const float*)(F.ws + WS_SMALL + S_A16);
    const int fr = F.lane & 15, fq = F.lane >> 4, c = 16 * F.wave + fr;
#pragma unroll
    for (int i = 0; i < 8; ++i) { const int f = F.wave * 8 + i; __builtin_amdgcn_global_load_lds((const unsigned*)(WINM + f * 512 + F.lane * 8), (LAS unsigned*)(L + f * 1024), 16, 0, 0); }
    bf16x8 uf[8];
    { const bf16* up = U + ((size_t)(b * 2048 + 16 * c + (fq >> 1)) * 2048 + 16 * g + 8 * (fq & 1));
#pragma unroll
      for (int kk = 0; kk < 8; ++kk) uf[kk] = *(const bf16x8*)(up + (size_t)2 * kk * 2048); }
    asm volatile("s_waitcnt vmcnt(0)" ::: "memory"); __syncthreads();
#pragma unroll
    for (int ft = 0; ft < 8; ++ft) { f32x4 acc = {0.f, 0.f, 0.f, 0.f};
#pragma unroll
        for (int kk = 0; kk < 8; ++kk) { const bf16x8 a = *(const LAS bf16x8*)(L + (ft * 8 + kk) * 1024 + F.lane * 16); acc = MFMA16(a, uf[kk], acc); }
        *(LAS f32x4*)(VL + c * 132 + 16 * ft + 4 * fq) = acc; }
    __syncthreads();
    if (F.tid < 64) { const int n = F.tid; const float ar = A16[(g * 64 + n) * 2], ai = A16[(g * 64 + n) * 2 + 1]; float sr = 0.f, si = 0.f;
        for (int cc = 0; cc < 128; ++cc) { SP[cc * 136 + n] = (bf16)f2bf(sr); SP[cc * 136 + 64 + n] = (bf16)f2bf(si);
            const float vr = VL[cc * 132 + n], vi = VL[cc * 132 + 64 + n]; const float nsr = ar * sr - ai * si + vr, nsi = ar * si + ai * sr + vi; sr = nsr; si = nsi; } }
    __syncthreads();
    bf16x8 sf[4];
#pragma unroll
    for (int k2 = 0; k2 < 4; ++k2) sf[k2] = *(const LAS bf16x8*)(SP + c * 136 + 32 * k2 + 8 * fq);
    asm volatile("s_waitcnt lgkmcnt(0)" ::: "memory"); __syncthreads();
#pragma unroll 1
    for (int i = 0; i < 17; ++i) { const int slot = F.wave * 17 + i; const bf16* src;
        if (slot < 72) { int sl = slot, jt = 0; while (sl >= (jt >> 1) + 1) { sl -= (jt >> 1) + 1; ++jt; } src = MG + (jt * 8 + sl) * 512; }
        else src = WOUTM + (slot - 72) * 512;
        __builtin_amdgcn_global_load_lds((const unsigned*)(src + F.lane * 8), (LAS unsigned*)(L + slot * 1024), 16, 0, 0); }
    const f32x4 d4 = *(const f32x4*)(dskip + 16 * g + 4 * fq);
    asm volatile("s_waitcnt vmcnt(0)" ::: "memory"); __syncthreads();
#pragma unroll
    for (int jt = 0; jt < 16; ++jt) { f32x4 acc = {0.f, 0.f, 0.f, 0.f};
        const int ms = (jt & 1) ? ((jt >> 1) + 1) * ((jt >> 1) + 1) : (jt >> 1) * ((jt >> 1) + 1);
#pragma unroll
        for (int kk = 0; kk < 8; ++kk) if (2 * kk <= jt) { const bf16x8 a = *(const LAS bf16x8*)(L + (ms + kk) * 1024 + F.lane * 16); acc = MFMA16(a, uf[kk], acc); }
#pragma unroll
        for (int k2 = 0; k2 < 4; ++k2) { const bf16x8 a = *(const LAS bf16x8*)(L + (72 + jt * 4 + k2) * 1024 + F.lane * 16); acc = MFMA16(a, sf[k2], acc); }
        const size_t off = (size_t)(b * 2048 + 16 * c + jt) * 2048 + 16 * g + 4 * fq;
        const v2u ub = *(const v2u*)(U + off);
        const float u0 = __builtin_bit_cast(float, ub.x << 16), u1 = __builtin_bit_cast(float, ub.x & 0xffff0000u), u2 = __builtin_bit_cast(float, ub.y << 16), u3 = __builtin_bit_cast(float, ub.y & 0xffff0000u);
        const float z0 = gelu_tanh(acc[0] + d4[0] * u0), z1 = gelu_tanh(acc[1] + d4[1] * u1), z2 = gelu_tanh(acc[2] + d4[2] * u2), z3 = gelu_tanh(acc[3] + d4[3] * u3);
        v2u w; w.x = pk2(z0, z1); w.y = pk2(z2, z3); *(v2u*)(Z + off) = w; }
    __syncthreads();
}

__device__ __forceinline__ int crow(int r, int hi) { return (r & 3) + 8 * (r >> 2) + 4 * hi; }
__device__ __forceinline__ void attn_dma(LAS unsigned char* ring, int st, int s, int wid, int lane, const bf16* Kb, const bf16* VT, size_t rowbase, int b, int h) {
    asm volatile("" : "+v"(lane));
    LAS unsigned char* stg = ring + st * 32768;
    if (wid < 4) { const int jj = wid >> 1;
#pragma unroll
        for (int i = 0; i < 4; ++i) { const int sk = (wid & 1) * 4 + i, row = 4 * sk + (lane >> 4), cc = (lane & 15) ^ (row & 15);
            const bf16* src = (Kb + (rowbase + 32 * s) * 2048 + h * 256 + jj * 128) + (unsigned)(row * 2048 + 8 * cc);
            __builtin_amdgcn_global_load_lds((const unsigned*)src, (LAS unsigned*)(stg + jj * 8192 + sk * 1024), 16, 0, 0); }
    } else {
#pragma unroll
        for (int i = 0; i < 4; ++i) { const int sv = (wid - 4) * 4 + i, d = 16 * sv + (lane >> 2), cc = (lane & 3) ^ ((d >> 2) & 3);
            const bf16* src = (VT + (size_t)(b * 8 + h) * 256 * 2048 + 32 * s) + (unsigned)(d * 2048 + 8 * cc);
            __builtin_amdgcn_global_load_lds((const unsigned*)src, (LAS unsigned*)(stg + 16384 + sv * 1024), 16, 0, 0); }
    }
}
template <int J> __device__ __forceinline__ void attn_unit(Frame& F, int b, int h, int qb, float lam, bf16* Ob) {
    LAS unsigned char* ring = F.lds; LAS float* wsf = (LAS float*)(F.lds + RING_BYTES) + F.wave * 64; LAS float* XO = (LAS float*)F.lds;
    const bf16* Qb = (const bf16*)(F.ws + WS_R + R_Q); const bf16* Kb = (const bf16*)(F.ws + WS_R + R_K); const bf16* VT = (const bf16*)(F.ws + WS_R + R_VT);
    int lane = F.lane; asm volatile("" : "+v"(lane)); const int wid = F.wave, wq = wid & 3; constexpr int j = J;     const int r32 = lane & 31, hi = lane >> 5;
    const int q0 = qb * 128, qw0 = q0 + wq * 32; const size_t rowbase = (size_t)b * 2048;
    const int NS = 4 * (qb + 1);
    bf16x8 qf[8];
    { const bf16* qp = (Qb + (rowbase + qw0) * 2048 + h * 256 + j * 128) + (unsigned)(r32 * 2048 + hi * 8);
#pragma unroll
      for (int ks = 0; ks < 8; ++ks) qf[ks] = *(const bf16x8*)(qp + ks * 16); }
    attn_dma(ring, 0, 0, wid, lane, Kb, VT, rowbase, b, h);
    attn_dma(ring, 1, 1, wid, lane, Kb, VT, rowbase, b, h);
    f32x16 o[8];
#pragma unroll
    for (int dt = 0; dt < 8; ++dt)
#pragma unroll
        for (int r = 0; r < 16; ++r) o[dt][r] = 0.f;
    float mrow = -1e30f, lrow = 0.f;
    for (int s0 = 0; s0 < NS; s0 += 2) {
        asm volatile("s_waitcnt vmcnt(0)" ::: "memory"); __syncthreads();
        if (s0 + 2 < NS) { attn_dma(ring, (s0 + 2) & 3, s0 + 2, wid, lane, Kb, VT, rowbase, b, h); attn_dma(ring, (s0 + 3) & 3, s0 + 3, wid, lane, Kb, VT, rowbase, b, h); }
        if constexpr (J == 0) {
#pragma unroll 1
            for (int s = s0; s < s0 + 2; ++s) {
                const int kvh = 32 * s;
                if (kvh > qw0 + 31) break;
            const LAS unsigned char* stg = ring + (s & 3) * 32768;
            f32x16 p;
    #pragma unroll
            for (int r = 0; r < 16; ++r) p[r] = 0.f;
            { const LAS unsigned char* kb = stg + j * 8192 + r32 * 256; bf16x8 kf[4];
    #pragma unroll
              for (int ks = 0; ks < 4; ++ks) kf[ks] = *(const LAS bf16x8*)(kb + (((2 * ks + hi) ^ (r32 & 15)) * 16));
              __builtin_amdgcn_sched_barrier(0);
    #pragma unroll
              for (int ks = 0; ks < 4; ++ks) { p = MFMA32(kf[ks], qf[ks], p); kf[ks] = *(const LAS bf16x8*)(kb + (((2 * (ks + 4) + hi) ^ (r32 & 15)) * 16)); }
              __builtin_amdgcn_sched_barrier(0);
    #pragma unroll
              for (int ks = 0; ks < 4; ++ks) p = MFMA32(kf[ks], qf[ks + 4], p); }
            const LAS unsigned char* vb = stg + 16384 + r32 * 64;
            const int g4 = (r32 >> 2) & 3; const int c0 = (hi ^ g4) * 16, c1 = ((2 + hi) ^ g4) * 16;
            if (kvh + 31 > qw0) {
    #pragma unroll
                for (int r = 0; r < 16; ++r) if (kvh + crow(r, hi) > qw0 + r32) p[r] = -INFINITY;
            }
            float mx = p[0];
    #pragma unroll
            for (int r = 1; r < 16; ++r) mx = fmaxf(mx, p[r]);
            { auto rr = __builtin_amdgcn_permlane32_swap(__float_as_uint(mx), __float_as_uint(mx), false, false); mx = fmaxf(__uint_as_float(rr[0]), __uint_as_float(rr[1])); }
            if (__any(mx > mrow + 8.f)) {
                const float mnew = fmaxf(mrow, mx);
                const float f = __builtin_amdgcn_exp2f(mrow - mnew); lrow *= f; mrow = mnew;
                if (hi == 0) wsf[r32] = f;
                asm volatile("s_waitcnt lgkmcnt(0)" ::: "memory");
    #pragma unroll
                for (int r4 = 0; r4 < 4; ++r4) { const f32x4 f4 = *(const LAS f32x4*)(wsf + 8 * r4 + 4 * hi);
    #pragma unroll
                    for (int dt = 0; dt < 8; ++dt)
    #pragma unroll
                        for (int e = 0; e < 4; ++e) o[dt][4 * r4 + e] *= f4[e]; }
            }
            bf16x8 va[4];
            va[0] = *(const LAS bf16x8*)(vb + c0); va[1] = *(const LAS bf16x8*)(vb + c1);
            __builtin_amdgcn_sched_barrier(0);
            float ls = 0.f;
    #pragma unroll
            for (int r = 0; r < 16; ++r) { p[r] = __builtin_amdgcn_exp2f(p[r] - mrow); ls += p[r]; }
            lrow += ls;
            v4u pw0, pw1;
            pw0.x = pk2(p[0], p[1]); pw0.y = pk2(p[2], p[3]); pw0.z = pk2(p[4], p[5]); pw0.w = pk2(p[6], p[7]);
            pw1.x = pk2(p[8], p[9]); pw1.y = pk2(p[10], p[11]); pw1.z = pk2(p[12], p[13]); pw1.w = pk2(p[14], p[15]);
            const bf16x8 pa0 = __builtin_bit_cast(bf16x8, pw0), pa1 = __builtin_bit_cast(bf16x8, pw1);
            va[2] = *(const LAS bf16x8*)(vb + 2048 + c0); va[3] = *(const LAS bf16x8*)(vb + 2048 + c1);
            __builtin_amdgcn_sched_barrier(0);
    #pragma unroll
            for (int dt = 0; dt < 8; ++dt) { const int k2 = (dt & 1) * 2;
                o[dt] = MFMA32(pa0, va[k2], o[dt]); o[dt] = MFMA32(pa1, va[k2 + 1], o[dt]);
                if (dt + 2 < 8) { va[k2] = *(const LAS bf16x8*)(vb + (dt + 2) * 2048 + c0); va[k2 + 1] = *(const LAS bf16x8*)(vb + (dt + 2) * 2048 + c1); }
                __builtin_amdgcn_sched_barrier(0);
            }
            }
        } else {
            const int s = s0;
            const int kvh = 32 * s;
            if (kvh > qw0 + 31) continue;
            const bool two = (kvh + 32 <= qw0 + 31);
            const LAS unsigned char* stg0 = ring + (s & 3) * 32768; const LAS unsigned char* stg1 = ring + ((s + 1) & 3) * 32768;
            f32x16 p0, p1;
    #pragma unroll
            for (int r = 0; r < 16; ++r) { p0[r] = 0.f; p1[r] = 0.f; }
            { const LAS unsigned char* kb0 = stg0 + j * 8192 + r32 * 256; const LAS unsigned char* kb1 = stg1 + j * 8192 + r32 * 256;
              __builtin_amdgcn_s_setprio(1);
              int zk = (hi ^ (r32 & 15)) * 16; asm volatile("" : "+v"(zk));
    #pragma unroll
              for (int ks = 0; ks < 8; ++ks) { const int co = zk ^ (32 * ks);
                  const bf16x8 k0 = *(const LAS bf16x8*)(kb0 + co); const bf16x8 k1 = *(const LAS bf16x8*)(kb1 + co);
                  p0 = MFMA32(k0, qf[ks], p0); p1 = MFMA32(k1, qf[ks], p1);
                  __builtin_amdgcn_sched_barrier(0); }
              __builtin_amdgcn_s_setprio(0); }
            if (kvh + 63 > qw0) {
    #pragma unroll
                for (int r = 0; r < 16; ++r) { if (kvh + crow(r, hi) > qw0 + r32) p0[r] = -INFINITY; if (kvh + 32 + crow(r, hi) > qw0 + r32) p1[r] = -INFINITY; }
            }
            float mx = fmaxf(p0[0], p1[0]);
    #pragma unroll
            for (int r = 1; r < 16; ++r) mx = fmaxf(fmaxf(mx, p0[r]), p1[r]);
            { auto rr = __builtin_amdgcn_permlane32_swap(__float_as_uint(mx), __float_as_uint(mx), false, false); mx = fmaxf(__uint_as_float(rr[0]), __uint_as_float(rr[1])); }
            if (__any(mx > mrow + 8.f)) {
                const float mnew = fmaxf(mrow, mx);
                const float f = __builtin_amdgcn_exp2f(mrow - mnew); lrow *= f; mrow = mnew;
                if (hi == 0) wsf[r32] = f;
                asm volatile("s_waitcnt lgkmcnt(0)" ::: "memory");
    #pragma unroll
                for (int r4 = 0; r4 < 4; ++r4) { const f32x4 f4 = *(const LAS f32x4*)(wsf + 8 * r4 + 4 * hi);
    #pragma unroll
                    for (int dt = 0; dt < 8; ++dt)
    #pragma unroll
                        for (int e = 0; e < 4; ++e) o[dt][4 * r4 + e] *= f4[e]; }
            }
            float ls = 0.f;
    #pragma unroll
            for (int r = 0; r < 16; ++r) { p0[r] = __builtin_amdgcn_exp2f(p0[r] - mrow); p1[r] = __builtin_amdgcn_exp2f(p1[r] - mrow); ls += p0[r] + p1[r]; }
            lrow += ls;
            v4u pw0, pw1, pw2, pw3;
            pw0.x = pk2(p0[0], p0[1]); pw0.y = pk2(p0[2], p0[3]); pw0.z = pk2(p0[4], p0[5]); pw0.w = pk2(p0[6], p0[7]);
            pw1.x = pk2(p0[8], p0[9]); pw1.y = pk2(p0[10], p0[11]); pw1.z = pk2(p0[12], p0[13]); pw1.w = pk2(p0[14], p0[15]);
            pw2.x = pk2(p1[0], p1[1]); pw2.y = pk2(p1[2], p1[3]); pw2.z = pk2(p1[4], p1[5]); pw2.w = pk2(p1[6], p1[7]);
            pw3.x = pk2(p1[8], p1[9]); pw3.y = pk2(p1[10], p1[11]); pw3.z = pk2(p1[12], p1[13]); pw3.w = pk2(p1[14], p1[15]);
            const bf16x8 pa0 = __builtin_bit_cast(bf16x8, pw0), pa1 = __builtin_bit_cast(bf16x8, pw1), pa2 = __builtin_bit_cast(bf16x8, pw2), pa3 = __builtin_bit_cast(bf16x8, pw3);
            const LAS unsigned char* vb0 = stg0 + 16384 + r32 * 64; const LAS unsigned char* vb1 = stg1 + 16384 + r32 * 64;
            const int g4 = (r32 >> 2) & 3; const int c0 = (hi ^ g4) * 16, c1 = ((2 + hi) ^ g4) * 16;
            __builtin_amdgcn_sched_barrier(0);
            __builtin_amdgcn_s_setprio(1);
    #pragma unroll
            for (int dt = 0; dt < 8; ++dt) {
                const bf16x8 v0 = *(const LAS bf16x8*)(vb0 + dt * 2048 + c0), v1 = *(const LAS bf16x8*)(vb0 + dt * 2048 + c1);
                o[dt] = MFMA32(pa0, v0, o[dt]); o[dt] = MFMA32(pa1, v1, o[dt]);
                __builtin_amdgcn_sched_barrier(0);
                if (two) { const bf16x8 v2 = *(const LAS bf16x8*)(vb1 + dt * 2048 + c0), v3 = *(const LAS bf16x8*)(vb1 + dt * 2048 + c1);
                    o[dt] = MFMA32(pa2, v2, o[dt]); o[dt] = MFMA32(pa3, v3, o[dt]); }
                __builtin_amdgcn_sched_barrier(0);
            }
            __builtin_amdgcn_s_setprio(0);
        }
    }
    int le_ = F.tid & 63; asm volatile("" : "+v"(le_)); const int r32e = le_ & 31, hie = le_ >> 5;
    { auto rr = __builtin_amdgcn_permlane32_swap(__float_as_uint(lrow), __float_as_uint(lrow), false, false); lrow = __uint_as_float(rr[0]) + __uint_as_float(rr[1]); }
    { const float linv = (j == 1 ? lam : 1.f) / lrow;
      if (hie == 0) wsf[r32e] = linv; }
    asm volatile("s_waitcnt lgkmcnt(0)" ::: "memory");
#pragma unroll
    for (int r4 = 0; r4 < 4; ++r4) { const f32x4 f4 = *(const LAS f32x4*)(wsf + 8 * r4 + 4 * hie);
#pragma unroll
        for (int dt = 0; dt < 8; ++dt)
#pragma unroll
            for (int e = 0; e < 4; ++e) o[dt][4 * r4 + e] *= f4[e]; }
    __syncthreads();
    if (j == 1) {
#pragma unroll
        for (int dt = 0; dt < 8; ++dt)
#pragma unroll
            for (int r = 0; r < 16; ++r) XO[(wq * 32 + crow(r, hie)) * 256 + 32 * dt + r32e] = o[dt][r];
    }
    __syncthreads();
    if (j == 0) {
#pragma unroll
        for (int dt = 0; dt < 8; ++dt) {
#pragma unroll
            for (int r = 0; r < 16; ++r) { LAS float* xp = XO + (wq * 32 + crow(r, hie)) * 256 + 32 * dt + r32e; *xp = o[dt][r] - *xp; }
            __builtin_amdgcn_sched_barrier(0); }
        asm volatile("s_waitcnt lgkmcnt(0)" ::: "memory");
        int l3 = lane; asm volatile("" : "+v"(l3));
        bf16* op = (Ob + (rowbase + qw0) * 2048 + h * 256) + (unsigned)((l3 >> 5) * 2048 + (l3 & 31) * 8);
        const LAS float* ip = XO + (wq * 32 + (l3 >> 5)) * 256 + (l3 & 31) * 8;
#pragma unroll 4
        for (int it = 0; it < 16; ++it) {
            const f32x4 a = *(const LAS f32x4*)(ip + it * 512), c = *(const LAS f32x4*)(ip + it * 512 + 4);
            float ss = (a[0] * a[0] + a[1] * a[1]) + (a[2] * a[2] + a[3] * a[3]) + (c[0] * c[0] + c[1] * c[1]) + (c[2] * c[2] + c[3] * c[3]);
#pragma unroll
            for (int sh = 1; sh < 32; sh <<= 1) ss += __shfl_xor(ss, sh);
            const float rn = rsqrtf(ss * (1.f / 256.f) + EPS);
            v4u w; w.x = pk2(a[0] * rn, a[1] * rn); w.y = pk2(a[2] * rn, a[3] * rn); w.z = pk2(c[0] * rn, c[1] * rn); w.w = pk2(c[2] * rn, c[3] * rn);
            *(v4u*)(op + (size_t)it * 4096) = w;
        }
    }
    __syncthreads();
}

#define XB_TMO      128
#define XB_XCNT(j)  (256  + 64 * (j))
#define XB_XSUB(j)  (1280 + 64 * (j))
#define XB_XGEN(j)  (2304 + 64 * (j))
#define XB_TOP      3328
#define XB_TOPGEN   3392
#define XCD_BAR_WORDS 3456
#define XB_SPIN_CAP (1u << 18)

__device__ __forceinline__ unsigned xb_ld(unsigned* p)              { return __hip_atomic_load(p, __ATOMIC_RELAXED, __HIP_MEMORY_SCOPE_AGENT); }
__device__ __forceinline__ unsigned xb_add(unsigned* p, unsigned v) { return __hip_atomic_fetch_add(p, v, __ATOMIC_RELAXED, __HIP_MEMORY_SCOPE_AGENT); }
__device__ __forceinline__ unsigned xb_xcc_id() { return (unsigned)__builtin_amdgcn_s_getreg((3 << 11) | 20) & 0xFu; }
#define XB_SPIN(cond, bar) do { unsigned _sp = 0; while (cond) { __builtin_amdgcn_s_sleep(1); \
    if ((++_sp & 255u) == 0u) { if (xb_ld(&(bar)[XB_TMO])) break; if (_sp > XB_SPIN_CAP) { atomicAdd(&(bar)[XB_TMO], 1u); break; } } } } while (0)

struct XcdBarrier {
    unsigned* bar; unsigned x;
    volatile LAS unsigned* st;
};

__device__ __forceinline__ XcdBarrier xcd_barrier_post(unsigned* bar, volatile LAS unsigned* st) {
    XcdBarrier b; b.bar = bar; b.x = xb_xcc_id(); b.st = st;
    if (threadIdx.x == 0) (void)xb_add(&bar[XB_XCNT(b.x)], 1u);
    return b;
}
__device__ __forceinline__ void xcd_barrier_complete(unsigned* bar, unsigned x, unsigned& nloc, unsigned& nx) {
    const unsigned G = gridDim.x * gridDim.y * gridDim.z;
    unsigned sum, cnt, mine, sp = 0u;
    for (;;) {
        sum = 0u; cnt = 0u; mine = 0u;
#pragma unroll
        for (unsigned j = 0; j < 16; ++j) { const unsigned c = xb_ld(&bar[XB_XCNT(j)]); sum += c; cnt += (c > 0u) ? 1u : 0u; mine = (j == x) ? c : mine; }
        if (sum == G) break;
        __builtin_amdgcn_s_sleep(1);
        if ((++sp & 255u) == 0u) { if (xb_ld(&bar[XB_TMO])) break; if (sp > XB_SPIN_CAP) { atomicAdd(&bar[XB_TMO], 1u); break; } }
    }
    nloc = mine > 0u ? mine : 1u; nx = cnt > 0u ? cnt : 1u;
}

__device__ __forceinline__ void xcd_barrier(const XcdBarrier& b) {
    asm volatile("s_waitcnt vmcnt(0)" ::: "memory");
    __syncthreads();
    if (threadIdx.x == 0) {
        unsigned* bar = b.bar;
        __builtin_amdgcn_s_waitcnt(0);
        unsigned nloc = b.st[0], nx = b.st[1];
        if (nloc == 0u) { xcd_barrier_complete(bar, b.x, nloc, nx); b.st[0] = nloc; b.st[1] = nx; }
        const unsigned old = xb_add(&bar[XB_XSUB(b.x)], 1u);
        const unsigned gen = old / nloc;
        if (old + 1u == (gen + 1u) * nloc) {
            __builtin_amdgcn_fence(__ATOMIC_RELEASE, "agent");
            asm volatile("s_waitcnt vmcnt(0)" ::: "memory");
            const unsigned og = xb_add(&bar[XB_TOP], 1u);
            const unsigned tg = og / nx;
            if (og + 1u == (tg + 1u) * nx) xb_add(&bar[XB_TOPGEN], 1u);
            else XB_SPIN(xb_ld(&bar[XB_TOPGEN]) == tg, bar);
            __builtin_amdgcn_fence(__ATOMIC_ACQUIRE, "agent");
            xb_add(&bar[XB_XGEN(b.x)], 1u);
            asm volatile("s_waitcnt vmcnt(0)" ::: "memory");
        } else {
            XB_SPIN(xb_ld(&bar[XB_XGEN(b.x)]) == gen, bar);
            __builtin_amdgcn_fence(__ATOMIC_ACQUIRE, "agent");
            asm volatile("s_waitcnt vmcnt(0)" ::: "memory");
        }
    }
    __syncthreads();
}

__global__ void __launch_bounds__(512, 2) mega_fwd(Args args) {
    extern __shared__ __attribute__((aligned(16))) unsigned char lds[];
    cg::grid_group grid = cg::this_grid();
    Frame F;
    F.lds = (LAS unsigned char*)lds;
    F.tid = threadIdx.x; F.lane = F.tid & 63; F.wave = __builtin_amdgcn_readfirstlane(F.tid >> 6);
    F.G = gridDim.x; { const int bx = blockIdx.x; F.vcu = (F.G % 8 == 0) ? (bx % 8) * (F.G / 8) + bx / 8 : bx; }
    F.out = args.out; F.ws = args.ws;
    unsigned char* ws = args.ws;
    volatile LAS unsigned* MISC = (volatile LAS unsigned*)(F.lds + RING_BYTES + 3072);
    if (F.tid < 16) MISC[F.tid] = 0u;
    __syncthreads();
    XcdBarrier bar = xcd_barrier_post((unsigned*)(ws + WS_SMALL), MISC + 8);
    const int lo = args.ph_lo, hi = args.ph_hi;
#ifndef PH_MASK
#define PH_MASK 0x7fff
#endif
#define IN(k) (((PH_MASK >> (k)) & 1) && lo <= (k) && (k) < hi)
#define SEAM(k) do { if (IN(k) && IN((k) + 1)) { xcd_barrier(bar); } } while (0)
    bf16* XN = (bf16*)(ws + WS_XN); float* rsp = (float*)(ws + WS_SMALL + S_RSP); float* rstd = (float*)(ws + WS_SMALL + S_RSTD);
    bf16* FF0 = (bf16*)F.out; bf16* FF1 = (bf16*)(ws + WS_WIN);
    typedef pg8::StaticOrder SO;

    if (args.ph_lo < 0) grid.sync();
    if (IN(0)) { p0_prologue(F, args); } SEAM(0);
    if (IN(1)) { pg8::Gemm g{XN, (const bf16*)(ws + WS_WIN), M, D, D}; SO S; S.init(M, D, F.G, (int)blockIdx.x);
        pg8::EpiStore<0, false, true> E{(bf16*)(ws + WS_R + R_U), D, nullptr, rstd};
        pg8::gemm_phase<pg8::EpiStore<0, false, true>, SO, true, true>(F.lds, g, S, E); } SEAM(1);
    if (IN(2)) { for (int u = F.vcu; u < NG * 8; u += F.G) s5_unit(F, args.in[13], u & 7, u >> 3); } SEAM(2);
    if (IN(3)) { pg8::Gemm g{(const bf16*)(ws + WS_R + R_Z), (const bf16*)(ws + WS_WGLU), M, 2 * D, D}; SO S; S.init(M, 2 * D, F.G, (int)blockIdx.x);
        pg8::EpiGlu E{(bf16*)(ws + WS_R + R_MIX), rsp};
        pg8::gemm_phase<pg8::EpiGlu, SO, true, true>(F.lds, g, S, E); } SEAM(3);
    if (IN(4)) { rowpass<true>(F, args.in[0], (const bf16*)(ws + WS_R + R_MIX), rsp, 64, args.in[2], XN, rstd, nullptr); } SEAM(4);
#if STOP_STAGE != 1
    if (IN(5)) { pg8::Gemm g{XN, (const bf16*)(ws + WS_WUP0), M, FF, D}; SO S; S.init(M, FF, F.G, (int)blockIdx.x);
        pg8::EpiStore<1, false, true> E{(bf16*)(ws + WS_R), FF, nullptr, rstd};
        pg8::gemm_phase<pg8::EpiStore<1, false, true>, SO, true, true>(F.lds, g, S, E); } SEAM(5);
    if (IN(6)) { pg8::Gemm g{(const bf16*)(ws + WS_R), (const bf16*)(ws + WS_WDN0), M, D, FF}; SO S; S.init(M, D, F.G, (int)blockIdx.x);
        pg8::EpiStore<0, true> E{FF0, D, rsp, nullptr};
        pg8::gemm_phase<pg8::EpiStore<0, true>, SO, true, true>(F.lds, g, S, E); } SEAM(6);
    if (IN(7)) { rowpass<false>(F, XN, FF0, rsp, 32, args.in[4], XN, rstd, nullptr); } SEAM(7);
#if STOP_STAGE != 2
    if (IN(8)) { pg8::Gemm g{XN, (const bf16*)(ws + WS_WQKV), M, 3 * D, D}; SO S; S.init(M, 3 * D, F.G, (int)blockIdx.x);
        const float* cosT = (const float*)(ws + WS_SMALL + S_ROPE);
        pg8::EpiQKV E{(bf16*)(ws + WS_R + R_K), (bf16*)(ws + WS_R + R_VT), (bf16*)(ws + WS_R + R_Q), cosT, cosT + 2048 * 64, 0.08838834764831845f * 1.4426950408889634f, rstd};
        pg8::gemm_phase<pg8::EpiQKV, SO, true, true>(F.lds, g, S, E); } SEAM(8);
    if (IN(9)) {
        float lam;
        { const float a = args.in[18][F.lane] * args.in[19][F.lane] + args.in[18][F.lane + 64] * args.in[19][F.lane + 64];
          const float c = args.in[20][F.lane] * args.in[21][F.lane] + args.in[20][F.lane + 64] * args.in[21][F.lane + 64];
          lam = expf(wave_sum(a)) - expf(wave_sum(c)) + (0.8f - 0.6f * expf(-0.3f)); lam = __builtin_bit_cast(float, __builtin_amdgcn_readfirstlane(__builtin_bit_cast(int, lam))); }
        const int bh = F.vcu >> 2, s = F.vcu & 3; bf16* Odst = (bf16*)(ws + WS_R + R_O);
#pragma unroll 1
        for (int u = F.vcu; u < 1024; u += F.G) { const int i = u >> 8, v = u & 255, bh2 = v >> 2, sq = v & 3;
            const int qb = (i == 0) ? 15 - sq : (i == 1) ? 8 + sq : (i == 2) ? 7 - sq : sq; if (F.wave < 4) attn_unit<0>(F, bh2 >> 3, bh2 & 7, qb, lam, Odst); else attn_unit<1>(F, bh2 >> 3, bh2 & 7, qb, lam, Odst); }
    } SEAM(9);
    if (IN(10)) { pg8::Gemm g{(const bf16*)(ws + WS_R + R_O), (const bf16*)(ws + WS_WO), M, D, D}; SO S; S.init(M, D, F.G, (int)blockIdx.x);
        pg8::EpiStore<0, true> E{(bf16*)(ws + WS_R + R_MIX1), D, rsp, nullptr};
        pg8::gemm_phase<pg8::EpiStore<0, true>, SO, true, true>(F.lds, g, S, E); } SEAM(10);
    if (IN(11)) { rowpass<false>(F, XN, (const bf16*)(ws + WS_R + R_MIX1), rsp, 32, args.in[2] + D, XN, rstd, nullptr); } SEAM(11);
#if STOP_STAGE != 3
    if (IN(12)) { pg8::Gemm g{XN, (const bf16*)(ws + WS_WUP1), M, FF, D}; SO S; S.init(M, FF, F.G, (int)blockIdx.x);
        pg8::EpiStore<1, false, true> E{(bf16*)(ws + WS_R), FF, nullptr, rstd};
        pg8::gemm_phase<pg8::EpiStore<1, false, true>, SO, true, true>(F.lds, g, S, E); } SEAM(12);
    if (IN(13)) { pg8::Gemm g{(const bf16*)(ws + WS_R), (const bf16*)(ws + WS_WDN1), M, D, FF}; SO S; S.init(M, D, F.G, (int)blockIdx.x);
        pg8::EpiStore<0, true> E{FF1, D, rsp, nullptr};
        pg8::gemm_phase<pg8::EpiStore<0, true>, SO, true, true>(F.lds, g, S, E); } SEAM(13);
    if (IN(14)) { rowpass<false>(F, XN, FF1, rsp, 32, args.in[4] + D, nullptr, nullptr, F.out); }
#endif
#endif
#endif
#undef IN
#undef SEAM
}

extern "C" void kernel_launch(void* const* d_in, const int* in_sizes, int n_in, void* d_out, int out_size, void* d_ws, size_t ws_size, hipStream_t stream) {
    static int grid = 0;
    if (grid == 0) {
        if (n_in != 26 || out_size != M * D || ws_size < WS_END) { fprintf(stderr, "kernel_launch: unexpected shapes (n_in %d, out %d, ws %zu)\n", n_in, out_size, ws_size); grid = -1; return; }
        int dev = 0, cus = 0, per_cu = 0;
        hipGetDevice(&dev); hipDeviceGetAttribute(&cus, hipDeviceAttributeMultiprocessorCount, dev);
        hipFuncSetAttribute((const void*)mega_fwd, hipFuncAttributeMaxDynamicSharedMemorySize, LDS_BYTES);
        hipOccupancyMaxActiveBlocksPerMultiprocessor(&per_cu, (const void*)mega_fwd, 512, LDS_BYTES);
        (void)hipGetLastError();
        if (per_cu < 1) per_cu = 1;
        grid = cus;
    }
    if (grid < 0) return;
    Args a{};
    for (int i = 0; i < 26; ++i) a.in[i] = (const float*)d_in[i];
    a.out = (float*)d_out; a.ws = (unsigned char*)d_ws;
#ifndef LAUNCH_RANGES
#define LAUNCH_RANGES {0, 15}
#endif
    static const int ranges[][2] = {LAUNCH_RANGES};
    hipError_t e = hipSuccess;
    for (unsigned li = 0; li < sizeof(ranges) / sizeof(ranges[0]) && e == hipSuccess; ++li) {
        if (hipMemsetAsync((char*)d_ws + WS_SMALL, 0, 16384, stream) != hipSuccess) { fprintf(stderr, "kernel_launch: memset failed\n"); return; }
        a.ph_lo = ranges[li][0]; a.ph_hi = ranges[li][1];
        void* kargs[] = {&a};
        e = hipLaunchCooperativeKernel((const void*)mega_fwd, dim3(grid), dim3(512), kargs, LDS_BYTES, stream);
    }
    if (e != hipSuccess) fprintf(stderr, "cooperative launch failed: %s (grid %d)\n", hipGetErrorString(e), grid);
}
```

```cpp
#include <hip/hip_runtime.h>
#include <hip/hip_cooperative_groups.h>
#include <cstdio>
#include <cstdint>
namespace cg = cooperative_groups;
#ifndef STOP_STAGE
#define STOP_STAGE 0
#endif
namespace pg8 {
#define PG8_LAS __attribute__((address_space(3)))
typedef unsigned short bf16_t;
typedef short bf16x8 __attribute__((ext_vector_type(8)));
typedef float f32x4 __attribute__((ext_vector_type(4)));
typedef unsigned u32x4 __attribute__((ext_vector_type(4)));
constexpr int BM = 256, BK = 64, HALF = 128, HTB = HALF * BK * 2  , STAGE_BYTES = 8 * HTB, NXCD = 8, WGM = 4;

__host__ __device__ __forceinline__ int lds_byte(int r, int c) { const int st = (r >> 4) * 2 + (c >> 5), rr = r & 15, cc = c & 31, ob = rr * 64 + cc * 2; return st * 1024 + (ob ^ (((ob >> 9) & 1) << 5)); }
__host__ __device__ __forceinline__ void stage_rc(int b, int& R, int& C) { const int st = b / 1024, sb = b % 1024, swz = sb ^ (((sb >> 9) & 1) << 5); R = (st >> 1) * 16 + swz / 64; C = (st & 1) * 32 + (swz % 64) / 2; }
__host__ __device__ __forceinline__ int perm32(int rho) { const int n = rho >> 4, i = rho & 15; return 8 * (i >> 2) + 4 * n + (i & 3); }

struct Unit { int pm, pn; };
struct Gemm { const bf16_t* A; const bf16_t* Bt; int M, N, K; };

struct StaticOrder {
    int nM, nN, nwg, G, c;
    __host__ __device__ void init(int M, int N, int G_, int c_) { nM = M / BM; nN = N / BM; nwg = nM * nN; G = G_; c = c_; }
    __host__ __device__ bool next(int i, Unit& u) const {
        const long L = (long)i * G + c; if (L >= nwg) return false;
        int wgid = (int)L; { const int q = nwg / NXCD, r = nwg % NXCD, xcd = wgid % NXCD, off = wgid / NXCD; wgid = (xcd < r ? xcd * (q + 1) : r * (q + 1) + (xcd - r) * q) + off; }
        const int nig = WGM * nN, gid = wgid / nig, fm = gid * WGM, gsz = (nM - fm) < WGM ? (nM - fm) : WGM;
        u.pm = fm + ((wgid % nig) % gsz); u.pn = (wgid % nig) / gsz; return true;
    }
    __device__ __forceinline__ void a_ready(const Unit&) const {}
    __device__ __forceinline__ void done(const Unit&) const {}
};

__device__ __forceinline__ unsigned cvt_pk_bf16(float lo, float hi) { unsigned r; asm volatile("v_cvt_pk_bf16_f32 %0, %1, %2" : "=v"(r) : "v"(lo), "v"(hi)); return r; }
template <class Epi, class Sched, bool ALIGN_EPI = false, bool SP2 = false>
__device__ __forceinline__ void gemm_phase(PG8_LAS unsigned char* lds, const Gemm g, const Sched& S, const Epi& E) {
    const int tid = threadIdx.x, wid = __builtin_amdgcn_readfirstlane(tid >> 6), lane = tid & 63, wr = wid >> 2, wc = wid & 3, fr = lane & 15, fq = lane >> 4;
    const int K = g.K, nt = K / BK;
    unsigned voffA[2], voffB[2];
#pragma unroll
    for (int i = 0; i < 2; ++i) { int R, C; stage_rc(tid * 16 + i * 8192, R, C); const int Rb = Epi::PERM ? ((R & ~31) + perm32(R & 31)) : R;
        voffA[i] = (unsigned)(R * K + C) * 2u; voffB[i] = (unsigned)(Rb * K + C) * 2u; }
    const size_t kstep = (size_t)(BK * 2);
    const size_t hstep = (size_t)HALF * K * 2;
    const size_t tstep = 2 * hstep;
    const unsigned ldsw = (unsigned)wid * 1024u;
    const int aoff = lds_byte(wr * 64 + fr, fq * 8), boff = lds_byte(wc * 32 + fr, fq * 8);
#define PG8_SA(b, h) (((b) * 2 + (h)) * HTB)
#define PG8_SB(b, h) ((4 + (b) * 2 + (h)) * HTB)
#define PG8_STAGE(bufoff, gbase, voff) do { _Pragma("unroll") for (int _i = 0; _i < 2; ++_i) \
        __builtin_amdgcn_global_load_lds((const unsigned*)((const char*)(gbase) + (voff)[_i]), (PG8_LAS unsigned*)(lds + (bufoff) + ldsw + _i * 8192), 16, 0, 0); } while (0)
#define PG8_LDA(dst, b, h) do { _Pragma("unroll") for (int m = 0; m < 4; ++m) _Pragma("unroll") for (int k = 0; k < 2; ++k) dst[m][k] = *(const PG8_LAS bf16x8*)(lds + PG8_SA(b, h) + aoff + m * 2048 + k * 1024); } while (0)
#define PG8_LDB(dst, b, h) do { _Pragma("unroll") for (int n = 0; n < 2; ++n) _Pragma("unroll") for (int k = 0; k < 2; ++k) dst[n][k] = *(const PG8_LAS bf16x8*)(lds + PG8_SB(b, h) + boff + n * 2048 + k * 1024); } while (0)
#define PG8_MMA(ai, bj, At, Bt) do { __builtin_amdgcn_s_setprio(1); _Pragma("unroll") for (int m = 0; m < 4; ++m) _Pragma("unroll") for (int n = 0; n < 2; ++n) _Pragma("unroll") for (int k = 0; k < 2; ++k) \
        acc[ai][bj][m][n] = __builtin_amdgcn_mfma_f32_16x16x32_bf16(Bt[n][k], At[m][k], acc[ai][bj][m][n], 0, 0, 0); __builtin_amdgcn_s_setprio(0); } while (0)
#define PG8_WAIT_V(n) asm volatile("s_waitcnt vmcnt(" #n ")" ::: "memory")
#define PG8_WAIT_L(n) asm volatile("s_waitcnt lgkmcnt(" #n ")" ::: "memory")
#define PG8_BAR __builtin_amdgcn_s_barrier()
#define PG8_SCHED __builtin_amdgcn_sched_barrier(0)
    Unit cur, nxt; int ui = 0;
    if (!S.next(0, cur)) return;
    f32x4 acc[2][2][4][2];
#pragma unroll
    for (int a = 0; a < 2; ++a)
#pragma unroll
        for (int b = 0; b < 2; ++b)
#pragma unroll
            for (int m = 0; m < 4; ++m)
#pragma unroll
                for (int n = 0; n < 2; ++n) acc[a][b][m][n] = (f32x4){0.f, 0.f, 0.f, 0.f};
    bf16x8 At[4][2], B0[2][2], B1[2][2];
    const char* cA = (const char*)g.A + (size_t)cur.pm * tstep; const char* cB = (const char*)g.Bt + (size_t)cur.pn * tstep;
    S.a_ready(cur);
    if constexpr (SP2) {
        PG8_STAGE(PG8_SB(0, 0), cB, voffB); PG8_STAGE(PG8_SB(0, 1), cB + hstep, voffB); PG8_STAGE(PG8_SA(0, 0), cA, voffA); PG8_STAGE(PG8_SA(0, 1), cA + hstep, voffA);
        if (wr == 1) PG8_BAR;
        PG8_WAIT_V(2); PG8_BAR;
        PG8_STAGE(PG8_SB(1, 0), cB + kstep, voffB); PG8_STAGE(PG8_SA(1, 0), cA + kstep, voffA); PG8_STAGE(PG8_SB(1, 1), cB + hstep + kstep, voffB);
        PG8_WAIT_V(6); PG8_BAR;
    } else {
        PG8_STAGE(PG8_SB(0, 0), cB, voffB); PG8_STAGE(PG8_SA(0, 0), cA, voffA); PG8_STAGE(PG8_SB(0, 1), cB + hstep, voffB); PG8_STAGE(PG8_SA(0, 1), cA + hstep, voffA);
        if (wr == 1) PG8_BAR;
        PG8_WAIT_V(4); PG8_BAR;
        PG8_STAGE(PG8_SB(1, 0), cB + kstep, voffB); PG8_STAGE(PG8_SA(1, 0), cA + kstep, voffA); PG8_STAGE(PG8_SB(1, 1), cB + hstep + kstep, voffB);
        PG8_WAIT_V(6); PG8_BAR;
    }
    for (;;) {
        const bool has_next = S.next(ui + 1, nxt);
        const char* nA = has_next ? (const char*)g.A + (size_t)nxt.pm * tstep : cA; const char* nB = has_next ? (const char*)g.Bt + (size_t)nxt.pn * tstep : cB;
        for (int t = 0; t < nt; t += 2) {
            const bool last = (t == nt - 2);
            const char* a1 = cA + (size_t)(t + 1) * kstep;
            const char* a2 = last ? nA : cA + (size_t)(t + 2) * kstep; const char* b2 = last ? nB : cB + (size_t)(t + 2) * kstep;
            const char* a3 = a2 + kstep; const char* b3 = b2 + kstep;
            if (last && has_next) S.a_ready(nxt);
            if constexpr (SP2) {
            PG8_LDB(B0, 0, 0); PG8_LDB(B1, 0, 1); PG8_SCHED; PG8_LDA(At, 0, 0); PG8_STAGE(PG8_SA(1, 1), a1 + hstep, voffA);
            PG8_WAIT_V(8); PG8_WAIT_L(0); PG8_BAR; PG8_MMA(0, 0, At, B0); PG8_MMA(0, 1, At, B1); PG8_BAR; PG8_SCHED;
            PG8_LDA(At, 0, 1); PG8_STAGE(PG8_SB(0, 0), b2, voffB); PG8_STAGE(PG8_SB(0, 1), b2 + hstep, voffB); PG8_STAGE(PG8_SA(0, 0), a2, voffA);
            PG8_WAIT_V(8); PG8_WAIT_L(0); PG8_BAR; PG8_MMA(1, 0, At, B0); PG8_MMA(1, 1, At, B1); PG8_BAR; PG8_SCHED;
            PG8_LDB(B0, 1, 0); PG8_LDB(B1, 1, 1); PG8_SCHED; PG8_LDA(At, 1, 0); PG8_STAGE(PG8_SA(0, 1), a2 + hstep, voffA);
            PG8_WAIT_V(8); PG8_WAIT_L(0); PG8_BAR; PG8_MMA(0, 0, At, B0); PG8_MMA(0, 1, At, B1); PG8_BAR; PG8_SCHED;
            PG8_LDA(At, 1, 1); PG8_STAGE(PG8_SB(1, 0), b3, voffB); PG8_STAGE(PG8_SB(1, 1), b3 + hstep, voffB); PG8_STAGE(PG8_SA(1, 0), a3, voffA);
            PG8_WAIT_V(8); PG8_WAIT_L(0); PG8_BAR; PG8_MMA(1, 0, At, B0); PG8_MMA(1, 1, At, B1); PG8_BAR; PG8_SCHED;
            } else {
            PG8_LDB(B0, 0, 0); PG8_SCHED; PG8_LDA(At, 0, 0); PG8_STAGE(PG8_SA(1, 1), a1 + hstep, voffA);
            PG8_WAIT_L(8); PG8_BAR; PG8_WAIT_L(0); PG8_MMA(0, 0, At, B0); PG8_BAR; PG8_SCHED;
            PG8_LDB(B1, 0, 1); PG8_STAGE(PG8_SB(0, 0), b2, voffB);
            PG8_BAR; PG8_WAIT_L(0); PG8_MMA(0, 1, At, B1); PG8_BAR;
            PG8_LDA(At, 0, 1); PG8_STAGE(PG8_SA(0, 0), a2, voffA);
            PG8_BAR; PG8_WAIT_L(0); PG8_MMA(1, 0, At, B0); PG8_BAR; PG8_SCHED;
            PG8_STAGE(PG8_SB(0, 1), b2 + hstep, voffB);
            PG8_WAIT_V(6); PG8_BAR; PG8_MMA(1, 1, At, B1); PG8_BAR;
            PG8_LDB(B0, 1, 0); PG8_SCHED; PG8_LDA(At, 1, 0); PG8_STAGE(PG8_SA(0, 1), a2 + hstep, voffA);
            PG8_WAIT_L(8); PG8_BAR; PG8_WAIT_L(0); PG8_MMA(0, 0, At, B0); PG8_BAR; PG8_SCHED;
            PG8_LDB(B1, 1, 1); PG8_STAGE(PG8_SB(1, 0), b3, voffB);
            PG8_BAR; PG8_WAIT_L(0); PG8_MMA(0, 1, At, B1); PG8_BAR;
            PG8_LDA(At, 1, 1); PG8_STAGE(PG8_SA(1, 0), a3, voffA);
            PG8_BAR; PG8_WAIT_L(0); PG8_MMA(1, 0, At, B0); PG8_BAR; PG8_SCHED;
            PG8_STAGE(PG8_SB(1, 1), b3 + hstep, voffB);
            PG8_WAIT_V(6); PG8_BAR; PG8_MMA(1, 1, At, B1); PG8_BAR;
            }
        }
        if constexpr (ALIGN_EPI) { if (wr == 0) PG8_BAR; }
        if constexpr (!Epi::AFTER_DRAIN) { E(acc, cur, wr, wc, fr, fq); S.done(cur); }
        if (!has_next) break;
#pragma unroll
        for (int a = 0; a < 2; ++a)
#pragma unroll
            for (int b = 0; b < 2; ++b)
#pragma unroll
                for (int m = 0; m < 4; ++m)
#pragma unroll
                    for (int n = 0; n < 2; ++n) acc[a][b][m][n] = (f32x4){0.f, 0.f, 0.f, 0.f};
        cur = nxt; cA = nA; cB = nB; ++ui;
        if constexpr (ALIGN_EPI) { if (wr == 1) PG8_BAR; }
    }
    PG8_WAIT_V(0);
    if constexpr (!ALIGN_EPI) { if (wr == 0) PG8_BAR; }
    PG8_BAR;
    if constexpr (Epi::AFTER_DRAIN) { E.fused(acc, cur, wr, wc, fr, fq, lds, wid, lane); S.done(cur); }
#undef PG8_SA
#undef PG8_SB
#undef PG8_STAGE
#undef PG8_LDA
#undef PG8_LDB
#undef PG8_MMA
#undef PG8_WAIT_V
#undef PG8_WAIT_L
#undef PG8_BAR
#undef PG8_SCHED
}
}

#define GAS __attribute__((address_space(1)))
#define LAS __attribute__((address_space(3)))
typedef unsigned short bf16;
typedef unsigned v4u __attribute__((ext_vector_type(4)));
typedef unsigned v2u __attribute__((ext_vector_type(2)));
typedef float f32x4 __attribute__((ext_vector_type(4)));
typedef float f32x16 __attribute__((ext_vector_type(16)));
typedef short bf16x8 __attribute__((ext_vector_type(8)));

constexpr int M = 16384, D = 2048, SEQ = 2048, FF = 8192, NG = 128;
constexpr float EPS = 1e-6f;
constexpr size_t MiB = 1u << 20;
constexpr size_t WS_WIN = 0, WS_WGLU = 8 * MiB, WS_WUP0 = 24 * MiB, WS_WDN0 = 56 * MiB, WS_WQKV = 88 * MiB, WS_WO = 112 * MiB, WS_WUP1 = 120 * MiB, WS_WDN1 = 152 * MiB;
constexpr size_t WS_XN = 184 * MiB, WS_R = 248 * MiB, WS_SMALL = 504 * MiB, WS_END = 512 * MiB;
constexpr size_t R_U = 0, R_Z = 64 * MiB, R_MIX = 128 * MiB, R_MG = 192 * MiB, R_WINM = 208 * MiB, R_WOUTM = 216 * MiB;
constexpr size_t R_Q = 0, R_K = 64 * MiB, R_VT = 128 * MiB, R_O = 192 * MiB, R_MIX1 = 64 * MiB;
constexpr size_t S_ROPE = 1 * MiB, S_A16 = 2 * MiB, S_RSP = 3 * MiB, S_RSTD = 7 * MiB;
constexpr int RING_BYTES = 139264, LDS_BYTES = 143360;

__device__ __forceinline__ unsigned f2bf(float f) { unsigned u = __builtin_bit_cast(unsigned, f); return (u + 0x7fffu + ((u >> 16) & 1u)) >> 16; }
__device__ __forceinline__ unsigned pk2(float lo, float hi) { return pg8::cvt_pk_bf16(lo, hi); }
__device__ __forceinline__ float bf2f(unsigned short b) { return __builtin_bit_cast(float, (unsigned)b << 16); }
__device__ __forceinline__ float wave_sum(float v) {
#pragma unroll
    for (int o = 1; o < 64; o <<= 1) v += __shfl_xor(v, o);
    return v;
}

namespace pg8 {
template <int ACT, bool RS, bool SC = false> struct EpiStore {
    static constexpr bool PERM = true, AFTER_DRAIN = false;
    bf16_t* O; int ldc; float* rsp; const float* rstd;
    __device__ __forceinline__ void operator()(const f32x4 (&acc)[2][2][4][2], const Unit& u, int wr, int wc, int fr, int fq) const {
        const int row0 = u.pm * BM + wr * 64 + fr, col0 = u.pn * BM + wc * 32 + 8 * fq;
#pragma unroll
        for (int ai = 0; ai < 2; ++ai)
#pragma unroll
            for (int m = 0; m < 4; ++m) {
                const int row = row0 + ai * HALF + m * 16;
                bf16_t* rowp = O + (size_t)row * ldc + col0; float ss = 0.f;
#pragma unroll
                for (int bj = 0; bj < 2; ++bj) {
                    f32x4 v0 = acc[ai][bj][m][0], v1 = acc[ai][bj][m][1];
                    if (SC) { const float rsd = rstd[row]; v0 = v0 * rsd; v1 = v1 * rsd; }
                    if (ACT == 1) {
#pragma unroll
                        for (int e = 0; e < 4; ++e) { const float a = fmaxf(v0[e], 0.f), b = fmaxf(v1[e], 0.f); v0[e] = a * a; v1[e] = b * b; }
                    }
                    if (RS) ss += (v0[0] * v0[0] + v0[1] * v0[1]) + (v0[2] * v0[2] + v0[3] * v0[3]) + (v1[0] * v1[0] + v1[1] * v1[1]) + (v1[2] * v1[2] + v1[3] * v1[3]);
                    u32x4 w; w.x = cvt_pk_bf16(v0[0], v0[1]); w.y = cvt_pk_bf16(v0[2], v0[3]); w.z = cvt_pk_bf16(v1[0], v1[1]); w.w = cvt_pk_bf16(v1[2], v1[3]);
                    *(u32x4*)(rowp + bj * HALF) = w;
                }
                if (RS) { ss += __shfl_xor(ss, 16); ss += __shfl_xor(ss, 32); if (fq == 0) rsp[(size_t)row * 64 + u.pn * 4 + wc] = ss; }
            }
    }
};
struct EpiGlu {
    static constexpr bool PERM = true, AFTER_DRAIN = false;
    bf16_t* O; float* rsp;
    __device__ __forceinline__ void operator()(const f32x4 (&acc)[2][2][4][2], const Unit& u, int wr, int wc, int fr, int fq) const {
        const int row0 = u.pm * BM + wr * 64 + fr, col0 = u.pn * HALF + wc * 32 + 8 * fq;
#pragma unroll
        for (int ai = 0; ai < 2; ++ai)
#pragma unroll
            for (int m = 0; m < 4; ++m) {
                const int row = row0 + ai * HALF + m * 16; float ss = 0.f; float o[8];
#pragma unroll
                for (int n = 0; n < 2; ++n)
#pragma unroll
                    for (int e = 0; e < 4; ++e) { const float a = acc[ai][0][m][n][e], g = acc[ai][1][m][n][e]; const float r = a * __builtin_amdgcn_rcpf(1.f + __expf(-g)); o[4 * n + e] = r; ss += r * r; }
                u32x4 w; w.x = cvt_pk_bf16(o[0], o[1]); w.y = cvt_pk_bf16(o[2], o[3]); w.z = cvt_pk_bf16(o[4], o[5]); w.w = cvt_pk_bf16(o[6], o[7]);
                *(u32x4*)(O + (size_t)row * 2048 + col0) = w;
                ss += __shfl_xor(ss, 16); ss += __shfl_xor(ss, 32); if (fq == 0) rsp[(size_t)row * 64 + u.pn * 4 + wc] = ss;
            }
    }
};
struct EpiQKV {
    static constexpr bool PERM = true, AFTER_DRAIN = false;
    bf16_t *Kb, *VT, *Qb; const float* cosT; const float* sinT; float qscale; const float* rstd;
    __device__ __forceinline__ void operator()(const f32x4 (&acc)[2][2][4][2], const Unit& u, int wr, int wc, int fr, int fq) const {
        const int row0 = u.pm * BM + wr * 64 + fr;
        if (u.pn >= 8 && u.pn < 16) {
            const int h = u.pn - 8; const int op = (fr & 3) + ((fr >> 3) & 1) * 4 + ((fr >> 2) & 1) * 8;
#pragma unroll
            for (int ai = 0; ai < 2; ++ai)
#pragma unroll
                for (int m = 0; m < 4; ++m) {
                    const int row = row0 + ai * HALF + m * 16; const int b = row >> 11, t = row & 2047; const int tp = (t & ~15) + op;
                    bf16_t* base = VT + ((size_t)(b * 8 + h) * 256 + wc * 32 + 8 * fq) * 2048 + tp; const float rsd = rstd[row];
#pragma unroll
                    for (int bj = 0; bj < 2; ++bj)
#pragma unroll
                        for (int n = 0; n < 2; ++n)
#pragma unroll
                            for (int e = 0; e < 4; ++e) { const float v = acc[ai][bj][m][n][e] * rsd; base[(size_t)(bj * HALF + 4 * n + e) * 2048] = (bf16_t)(cvt_pk_bf16(v, v) & 0xffffu); }
                }
        } else {
            const bool isq = u.pn >= 16; bf16_t* basep = isq ? Qb : Kb; const int hp = isq ? u.pn - 16 : u.pn; const float sc = isq ? qscale : 1.f;
#pragma unroll
            for (int ai = 0; ai < 2; ++ai)
#pragma unroll
                for (int m = 0; m < 4; ++m) {
                    const int row = row0 + ai * HALF + m * 16; const int pos = row & 2047; const float rsc = rstd[row] * sc;
                    const f32x4 c4 = *(const f32x4*)(cosT + pos * 64 + wc * 16 + fq * 4), s4 = *(const f32x4*)(sinT + pos * 64 + wc * 16 + fq * 4);
#pragma unroll
                    for (int bj = 0; bj < 2; ++bj) {
                        const f32x4 x1 = acc[ai][bj][m][0], x2 = acc[ai][bj][m][1];
                        const f32x4 o1 = (x1 * c4 - x2 * s4) * rsc, o2 = (x2 * c4 + x1 * s4) * rsc;
                        bf16_t* p = basep + (size_t)row * 2048 + hp * 256 + bj * HALF + wc * 16 + fq * 4;
                        v2u w1, w2; w1.x = cvt_pk_bf16(o1[0], o1[1]); w1.y = cvt_pk_bf16(o1[2], o1[3]); w2.x = cvt_pk_bf16(o2[0], o2[1]); w2.y = cvt_pk_bf16(o2[2], o2[3]);
                        *(v2u*)p = w1; *(v2u*)(p + 64) = w2;
                    }
                }
        }
    }
};
}

struct Frame {
    LAS unsigned char* lds;
    int tid, lane, wave, vcu, G;
    float* out; unsigned char* ws;
};
struct Args { const float* in[26]; float* out; unsigned char* ws; int ph_lo, ph_hi; };

__device__ __forceinline__ int ropeperm(int c) { const int head = c >> 7, d = c & 127, n = d >> 6, rem = d & 63; return head * 128 + 32 * (rem >> 4) + 8 * ((rem >> 2) & 3) + 4 * n + (rem & 3); }
__device__ __forceinline__ int dstrow(int kind, int c) {
    if (kind == 1) { return c < 2048 ? ((c >> 7) * 256 + (c & 127)) : (((c - 2048) >> 7) * 256 + 128 + ((c - 2048) & 127)); }
    if (kind == 2) return ropeperm(c);
    if (kind == 3) return c < 2048 ? ropeperm(c) : c;
    return c;
}
__device__ __forceinline__ void transpose_item(const float* W, int K, int N, bf16* WT, int kind, int row_off, const float* gain, int gmask, float gscale, LAS float* scr, int item, int lane) {
    const int nblk = N / 32, kb = item / nblk, nb = item % nblk, k0 = 64 * kb, n0 = 32 * nb;
    f32x4 v[8]; float gg[8];
#pragma unroll
    for (int i = 0; i < 8; ++i) { const int kk = 8 * i + (lane >> 3); v[i] = *(const f32x4*)(W + (size_t)(k0 + kk) * N + n0 + 4 * (lane & 7)); gg[i] = gain ? gain[(k0 + kk) & gmask] * gscale : 1.f; }
#pragma unroll
    for (int i = 0; i < 8; ++i) { const int kk = 8 * i + (lane >> 3); LAS float* d = scr + kk * 33 + 4 * (lane & 7);
        d[0] = v[i][0] * gg[i]; d[1] = v[i][1] * gg[i]; d[2] = v[i][2] * gg[i]; d[3] = v[i][3] * gg[i]; }
    asm volatile("s_waitcnt lgkmcnt(0)" ::: "memory");
    const int c = lane & 7;
#pragma unroll
    for (int j = 0; j < 4; ++j) { const int n = (lane >> 3) + 8 * j; const LAS float* s = scr + (8 * c) * 33 + n;
        v4u o; o.x = pk2(s[0 * 33], s[1 * 33]); o.y = pk2(s[2 * 33], s[3 * 33]); o.z = pk2(s[4 * 33], s[5 * 33]); o.w = pk2(s[6 * 33], s[7 * 33]);
        *(v4u*)(WT + (size_t)(row_off + dstrow(kind, n0 + n)) * K + k0 + 8 * c) = o; }
    asm volatile("s_waitcnt lgkmcnt(0)" ::: "memory");
}

__device__ __forceinline__ void s5_build(Frame& F, const Args& A, int g) {
    LAS float* T = (LAS float*)F.lds;
    LAS float *AP_re = T, *AP_im = T + 1088, *BB_re = T + 2176, *BB_im = T + 3200, *CR = T + 4224, *CI = T + 5248, *KT = T + 6272;
    const float* a_re = A.in[6]; const float* a_im = A.in[7]; const float* log_dt = A.in[8]; const float* b_re = A.in[9]; const float* b_im = A.in[10]; const float* c_re = A.in[11]; const float* c_im = A.in[12];
    bf16* MG = (bf16*)(F.ws + WS_R + R_MG); bf16* WINM = (bf16*)(F.ws + WS_R + R_WINM); bf16* WOUTM = (bf16*)(F.ws + WS_R + R_WOUTM); float* A16 = (float*)(F.ws + WS_SMALL + S_A16);
    const int tid = F.tid;
    const float step = expf(log_dt[g]);
    __syncthreads();
    for (int e = tid; e < 1088; e += 512) { const int tau = e >> 6, n = e & 63; const float lre = fminf(a_re[g * 64 + n], -1e-4f), lim = a_im[g * 64 + n];
        const float mag = expf((float)tau * (step * lre)), ang = (float)tau * (step * lim); AP_re[e] = mag * cosf(ang); AP_im[e] = mag * sinf(ang); }
    for (int e = tid; e < 1024; e += 512) { CR[e] = c_re[g * 1024 + e]; CI[e] = c_im[g * 1024 + e]; }
    __syncthreads();
    for (int e = tid; e < 1024; e += 512) { const int n = e >> 4; const float lre = fminf(a_re[g * 64 + n], -1e-4f), lim = a_im[g * 64 + n];
        const float den = lre * lre + lim * lim, nr = AP_re[64 + n] - 1.f, ni = AP_im[64 + n];
        const float cr = (nr * lre + ni * lim) / den, ci = (ni * lre - nr * lim) / den; const float br = b_re[g * 1024 + e], bi = b_im[g * 1024 + e];
        BB_re[e] = cr * br - ci * bi; BB_im[e] = cr * bi + ci * br; }
    if (tid < 64) { A16[(g * 64 + tid) * 2] = AP_re[16 * 64 + tid]; A16[(g * 64 + tid) * 2 + 1] = AP_im[16 * 64 + tid]; }
    __syncthreads();
    for (int e = tid; e < 4096; e += 512) { const int tau = e >> 8, p = (e >> 4) & 15, q = e & 15; float acc = 0.f;
        for (int n = 0; n < 64; ++n) { const float ar = AP_re[tau * 64 + n], ai = AP_im[tau * 64 + n], br = BB_re[n * 16 + q], bi = BB_im[n * 16 + q];
            const float tr = ar * br - ai * bi, ti = ar * bi + ai * br; acc += CR[p * 64 + n] * tr - CI[p * 64 + n] * ti; }
        KT[e] = acc; }
    __syncthreads();
    for (int ch = tid; ch < 8192; ch += 512) { const int row = ch >> 5, j = row >> 4, p = row & 15, i = (ch & 31) >> 1, q0 = (ch & 1) * 8; float v[8];
#pragma unroll
        for (int e = 0; e < 8; ++e) v[e] = (i <= j) ? KT[((j - i) << 8) + (p << 4) + q0 + e] : 0.f;
        v4u o; o.x = pk2(v[0], v[1]); o.y = pk2(v[2], v[3]); o.z = pk2(v[4], v[5]); o.w = pk2(v[6], v[7]);
        *(v4u*)(MG + (size_t)g * 65536 + ((((row >> 4) * 8 + ((ch & 31) >> 2)) * 64) + (row & 15) + 16 * (ch & 3)) * 8) = o; }
    for (int ch = tid; ch < 4096; ch += 512) { const int np = ch >> 5, n = np & 63, im = np >> 6, i = (ch & 31) >> 1, q0 = (ch & 1) * 8, tau = 15 - i; float v[8];
        const float ar = AP_re[tau * 64 + n], ai = AP_im[tau * 64 + n];
#pragma unroll
        for (int e = 0; e < 8; ++e) { const float br = BB_re[n * 16 + q0 + e], bi = BB_im[n * 16 + q0 + e]; v[e] = im ? (ar * bi + ai * br) : (ar * br - ai * bi); }
        v4u o; o.x = pk2(v[0], v[1]); o.y = pk2(v[2], v[3]); o.z = pk2(v[4], v[5]); o.w = pk2(v[6], v[7]);
        *(v4u*)(WINM + (size_t)g * 32768 + ((((np >> 4) * 8 + ((ch & 31) >> 2)) * 64) + (np & 15) + 16 * (ch & 3)) * 8) = o; }
    for (int ch = tid; ch < 4096; ch += 512) { const int row = ch >> 4, j = row >> 4, p = row & 15, n0 = (ch & 15) * 8, im = n0 >> 6, tau = j + 1; float v[8];
#pragma unroll
        for (int e = 0; e < 8; ++e) { const int n = (n0 & 63) + e; const float ar = AP_re[tau * 64 + n], ai = AP_im[tau * 64 + n], cr = CR[p * 64 + n], ci = CI[p * 64 + n]; v[e] = im ? -(cr * ai + ci * ar) : (cr * ar - ci * ai); }
        v4u o; o.x = pk2(v[0], v[1]); o.y = pk2(v[2], v[3]); o.z = pk2(v[4], v[5]); o.w = pk2(v[6], v[7]);
        *(v4u*)(WOUTM + (size_t)g * 32768 + ((((row >> 4) * 4 + ((ch & 15) >> 2)) * 64) + (row & 15) + 16 * (ch & 3)) * 8) = o; }
    __syncthreads();
}

__device__ __forceinline__ void prologue_item(Frame& F, const Args& A, LAS float* scr, int it, float linit) {
    constexpr int I_SQ = 32 * 64, I_GLU = 32 * 128, I_UP = 32 * 256, I_DN = 128 * 64;
        int r = it;
        if (r < I_SQ) { transpose_item(A.in[5], D, D, (bf16*)(F.ws + WS_WIN), 0, 0, A.in[1], 0x7fffffff, 1.f, scr, r, F.lane); return; } r -= I_SQ;
        if (r < I_GLU) { transpose_item(A.in[14], D, 2 * D, (bf16*)(F.ws + WS_WGLU), 1, 0, nullptr, 0, 1.f, scr, r, F.lane); return; } r -= I_GLU;
        if (r < I_UP) { transpose_item(A.in[24], D, FF, (bf16*)(F.ws + WS_WUP0), 0, 0, A.in[3], 0x7fffffff, 1.f, scr, r, F.lane); return; } r -= I_UP;
        if (r < I_UP) { transpose_item(A.in[24] + (size_t)D * FF, D, FF, (bf16*)(F.ws + WS_WUP1), 0, 0, A.in[3] + D, 0x7fffffff, 1.f, scr, r, F.lane); return; } r -= I_UP;
        if (r < I_DN) { transpose_item(A.in[25], FF, D, (bf16*)(F.ws + WS_WDN0), 0, 0, nullptr, 0, 1.f, scr, r, F.lane); return; } r -= I_DN;
        if (r < I_DN) { transpose_item(A.in[25] + (size_t)D * FF, FF, D, (bf16*)(F.ws + WS_WDN1), 0, 0, nullptr, 0, 1.f, scr, r, F.lane); return; } r -= I_DN;
        if (r < I_GLU) { transpose_item(A.in[16], D, 2 * D, (bf16*)(F.ws + WS_WQKV), 3, 0, A.in[15], 0x7fffffff, 1.f, scr, r, F.lane); return; } r -= I_GLU;
        if (r < I_SQ) { transpose_item(A.in[17], D, D, (bf16*)(F.ws + WS_WQKV), 2, 4096, A.in[1] + D, 0x7fffffff, 1.f, scr, r, F.lane); return; } r -= I_SQ;
        transpose_item(A.in[23], D, D, (bf16*)(F.ws + WS_WO), 0, 0, A.in[22], 255, 1.f - linit, scr, r, F.lane);
}
__device__ __forceinline__ void p0_prologue(Frame& F, const Args& A) {
    for (int g = F.vcu; g < NG; g += F.G) s5_build(F, A, g);
    __syncthreads();
    LAS float* scr = (LAS float*)(F.lds + F.wave * 16384);
    const int gw = F.vcu * 8 + F.wave, NGW = F.G * 8;
    constexpr int I_SQ = 32 * 64, I_GLU = 32 * 128, I_UP = 32 * 256, I_DN = 128 * 64;
    constexpr int NITEMS = I_SQ + I_GLU + 2 * I_UP + 2 * I_DN + I_GLU + 2 * I_SQ;
    const float linit = 0.8f - 0.6f * expf(-0.3f);
    constexpr int NA = 47104;
    for (int it = gw; it < NA; it += NGW) prologue_item(F, A, scr, it, linit);
    if (F.G > NG) { if (F.vcu >= NG) for (int it = NA + gw - NG * 8; it < NITEMS; it += (F.G - NG) * 8) prologue_item(F, A, scr, it, linit); }
    else for (int it = NA + gw; it < NITEMS; it += NGW) prologue_item(F, A, scr, it, linit);
    { const float* x = A.in[0]; bf16* XN = (bf16*)(F.ws + WS_XN); float* rstd = (float*)(F.ws + WS_SMALL + S_RSTD);
      for (int m = gw; m < M; m += NGW) { const f32x4* xr = (const f32x4*)(x + (size_t)m * D) + F.lane; f32x4 v[8]; float ss = 0.f;
#pragma unroll
          for (int j = 0; j < 8; ++j) { v[j] = xr[64 * j]; ss += (v[j].x * v[j].x + v[j].y * v[j].y) + (v[j].z * v[j].z + v[j].w * v[j].w); }
          const float r = rsqrtf(wave_sum(ss) * (1.f / D) + EPS); if (F.lane == 0) rstd[m] = r;
          v2u* o = (v2u*)(XN + (size_t)m * D) + F.lane;
#pragma unroll
          for (int j = 0; j < 8; ++j) { v2u w; w.x = pk2(v[j].x, v[j].y); w.y = pk2(v[j].z, v[j].w); o[64 * j] = w; } } }
    { float* cosT = (float*)(F.ws + WS_SMALL + S_ROPE); float* sinT = cosT + 2048 * 64;
      for (int e = (F.vcu * 512 + F.tid); e < 2048 * 64; e += F.G * 512) { const int pos = e >> 6, i = e & 63;
          const float inv = 1.0f / powf(10000.0f, (float)i * (1.0f / 64.0f)); const float ang = (float)pos * inv; cosT[e] = cosf(ang); sinT[e] = sinf(ang); } }
}

template <bool IN_F32> __device__ __forceinline__ void rowpass(Frame& F, const void* hin_, const bf16* y, const float* rsp, int nslots, const float* gpost, bf16* hout, float* rstd, float* fout) {
    const int gw = F.vcu * 8 + F.wave, NGW = F.G * 8;
    for (int m = gw; m < M; m += NGW) {
        float part = (F.lane < nslots) ? rsp[(size_t)m * 64 + F.lane] : 0.f; part = wave_sum(part);
        const float ry = rsqrtf(part * (1.f / D) + EPS);
        f32x4 hv[8]; float ss = 0.f;
#pragma unroll
        for (int j = 0; j < 8; ++j) { const int idx = j * 256 + F.lane * 4; f32x4 h4;
            if (IN_F32) h4 = *(const f32x4*)((const float*)hin_ + (size_t)m * D + idx);
            else { const v2u hb = *(const v2u*)((const bf16*)hin_ + (size_t)m * D + idx); h4.x = __builtin_bit_cast(float, hb.x << 16); h4.y = __builtin_bit_cast(float, hb.x & 0xffff0000u); h4.z = __builtin_bit_cast(float, hb.y << 16); h4.w = __builtin_bit_cast(float, hb.y & 0xffff0000u); }
            const v2u yb = *(const v2u*)(y + (size_t)m * D + idx); const f32x4 g4 = *(const f32x4*)(gpost + idx);
            f32x4 yv; yv.x = __builtin_bit_cast(float, yb.x << 16); yv.y = __builtin_bit_cast(float, yb.x & 0xffff0000u); yv.z = __builtin_bit_cast(float, yb.y << 16); yv.w = __builtin_bit_cast(float, yb.y & 0xffff0000u);
            hv[j] = h4 + yv * ry * g4; ss += (hv[j].x * hv[j].x + hv[j].y * hv[j].y) + (hv[j].z * hv[j].z + hv[j].w * hv[j].w); }
        if (fout) {
#pragma unroll
            for (int j = 0; j < 8; ++j) *(f32x4*)(fout + (size_t)m * D + j * 256 + F.lane * 4) = hv[j];
        } else {
            const float rh = rsqrtf(wave_sum(ss) * (1.f / D) + EPS); if (F.lane == 0) rstd[m] = rh;
#pragma unroll
            for (int j = 0; j < 8; ++j) { v2u w; w.x = pk2(hv[j].x, hv[j].y); w.y = pk2(hv[j].z, hv[j].w); *(v2u*)(hout + (size_t)m * D + j * 256 + F.lane * 4) = w; }
        }
    }
}

#define MFMA16(a, b, c) __builtin_amdgcn_mfma_f32_16x16x32_bf16((a), (b), (c), 0, 0, 0)
#define MFMA32(a, b, c) __builtin_amdgcn_mfma_f32_32x32x16_bf16((a), (b), (c), 0, 0, 0)
__device__ __forceinline__ float gelu_tanh(float y) { return y * __builtin_amdgcn_rcpf(1.f + __expf(-1.5957691216057308f * (y + 0.044715f * y * y * y))); }
__device__ __forceinline__ void s5_unit(Frame& F, const float* dskip, int b, int g) {
    LAS unsigned char* L = F.lds;
    LAS float* VL = (LAS float*)(F.lds + 65536);
    LAS bf16* SP = (LAS bf16*)F.lds;
    const bf16* U = (const bf16*)(F.ws + WS_R + R_U); bf16* Z = (bf16*)(F.ws + WS_R + R_Z);
    const bf16* MG = (const bf16*)(F.ws + WS_R + R_MG) + (size_t)g * 65536; const bf16* WINM = (const bf16*)(F.ws + WS_R + R_WINM) + (size_t)g * 32768; const bf16* WOUTM = (const bf16*)(F.ws + WS_R + R_WOUTM) + (size_t)g * 32768;
    const float* A16 = (const float*)(F.ws + WS_SMALL + S_A16);
    const int fr = F.lane & 15, fq = F.lane >> 4, c = 16 * F.wave + fr;
#pragma unroll
    for (int i = 0; i < 8; ++i) { const int f = F.wave * 8 + i; __builtin_amdgcn_global_load_lds((const unsigned*)(WINM + f * 512 + F.lane * 8), (LAS unsigned*)(L + f * 1024), 16, 0, 0); }
    bf16x8 uf[8];
    { const bf16* up = U + ((size_t)(b * 2048 + 16 * c + (fq >> 1)) * 2048 + 16 * g + 8 * (fq & 1));
#pragma unroll
      for (int kk = 0; kk < 8; ++kk) uf[kk] = *(const bf16x8*)(up + (size_t)2 * kk * 2048); }
    asm volatile("s_waitcnt vmcnt(0)" ::: "memory"); __syncthreads();
#pragma unroll
    for (int ft = 0; ft < 8; ++ft) { f32x4 acc = {0.f, 0.f, 0.f, 0.f};
#pragma unroll
        for (int kk = 0; kk < 8; ++kk) { const bf16x8 a = *(const LAS bf16x8*)(L + (ft * 8 + kk) * 1024 + F.lane * 16); acc = MFMA16(a, uf[kk], acc); }
        *(LAS f32x4*)(VL + c * 132 + 16 * ft + 4 * fq) = acc; }
    __syncthreads();
    if (F.tid < 64) { const int n = F.tid; const float ar = A16[(g * 64 + n) * 2], ai = A16[(g * 64 + n) * 2 + 1]; float sr = 0.f, si = 0.f;
        for (int cc = 0; cc < 128; ++cc) { SP[cc * 136 + n] = (bf16)f2bf(sr); SP[cc * 136 + 64 + n] = (bf16)f2bf(si);
            const float vr = VL[cc * 132 + n], vi = VL[cc * 132 + 64 + n]; const float nsr = ar * sr - ai * si + vr, nsi = ar * si + ai * sr + vi; sr = nsr; si = nsi; } }
    __syncthreads();
    bf16x8 sf[4];
#pragma unroll
    for (int k2 = 0; k2 < 4; ++k2) sf[k2] = *(const LAS bf16x8*)(SP + c * 136 + 32 * k2 + 8 * fq);
    asm volatile("s_waitcnt lgkmcnt(0)" ::: "memory"); __syncthreads();
#pragma unroll 1
    for (int i = 0; i < 17; ++i) { const int slot = F.wave * 17 + i; const bf16* src;
        if (slot < 72) { int sl = slot, jt = 0; while (sl >= (jt >> 1) + 1) { sl -= (jt >> 1) + 1; ++jt; } src = MG + (jt * 8 + sl) * 512; }
        else src = WOUTM + (slot - 72) * 512;
        __builtin_amdgcn_global_load_lds((const unsigned*)(src + F.lane * 8), (LAS unsigned*)(L + slot * 1024), 16, 0, 0); }
    const f32x4 d4 = *(const f32x4*)(dskip + 16 * g + 4 * fq);
    asm volatile("s_waitcnt vmcnt(0)" ::: "memory"); __syncthreads();
#pragma unroll
    for (int jt = 0; jt < 16; ++jt) { f32x4 acc = {0.f, 0.f, 0.f, 0.f};
        const int ms = (jt & 1) ? ((jt >> 1) + 1) * ((jt >> 1) + 1) : (jt >> 1) * ((jt >> 1) + 1);
#pragma unroll
        for (int kk = 0; kk < 8; ++kk) if (2 * kk <= jt) { const bf16x8 a = *(const LAS bf16x8*)(L + (ms + kk) * 1024 + F.lane * 16); acc = MFMA16(a, uf[kk], acc); }
#pragma unroll
        for (int k2 = 0; k2 < 4; ++k2) { const bf16x8 a = *(const LAS bf16x8*)(L + (72 + jt * 4 + k2) * 1024 + F.lane * 16); acc = MFMA16(a, sf[k2], acc); }
        const size_t off = (size_t)(b * 2048 + 16 * c + jt) * 2048 + 16 * g + 4 * fq;
        const v2u ub = *(const v2u*)(U + off);
        const float u0 = __builtin_bit_cast(float, ub.x << 16), u1 = __builtin_bit_cast(float, ub.x & 0xffff0000u), u2 = __builtin_bit_cast(float, ub.y << 16), u3 = __builtin_bit_cast(float, ub.y & 0xffff0000u);
        const float z0 = gelu_tanh(acc[0] + d4[0] * u0), z1 = gelu_tanh(acc[1] + d4[1] * u1), z2 = gelu_tanh(acc[2] + d4[2] * u2), z3 = gelu_tanh(acc[3] + d4[3] * u3);
        v2u w; w.x = pk2(z0, z1); w.y = pk2(z2, z3); *(v2u*)(Z + off) = w; }
    __syncthreads();
}

__device__ __forceinline__ int crow(int r, int hi) { return (r & 3) + 8 * (r >> 2) + 4 * hi; }
__device__ __forceinline__ void attn_dma(LAS unsigned char* ring, int st, int s, int wid, int lane, const bf16* Kb, const bf16* VT, size_t rowbase, int b, int h) {
    asm volatile("" : "+v"(lane));
    LAS unsigned char* stg = ring + st * 32768;
    if (wid < 4) { const int jj = wid >> 1;
#pragma unroll
        for (int i = 0; i < 4; ++i) { const int sk = (wid & 1) * 4 + i, row = 4 * sk + (lane >> 4), cc = (lane & 15) ^ (row & 15);
            const bf16* src = (Kb + (rowbase + 32 * s) * 2048 + h * 256 + jj * 128) + (unsigned)(row * 2048 + 8 * cc);
            __builtin_amdgcn_global_load_lds((const unsigned*)src, (LAS unsigned*)(stg + jj * 8192 + sk * 1024), 16, 0, 0); }
    } else {
#pragma unroll
        for (int i = 0; i < 4; ++i) { const int sv = (wid - 4) * 4 + i, d = 16 * sv + (lane >> 2), cc = (lane & 3) ^ ((d >> 2) & 3);
            const bf16* src = (VT + (size_t)(b * 8 + h) * 256 * 2048 + 32 * s) + (unsigned)(d * 2048 + 8 * cc);
            __builtin_amdgcn_global_load_lds((const unsigned*)src, (LAS unsigned*)(stg + 16384 + sv * 1024), 16, 0, 0); }
    }
}
template <int J> __device__ __forceinline__ void attn_unit(Frame& F, int b, int h, int qb, float lam, bf16* Ob) {
    LAS unsigned char* ring = F.lds; LAS float* wsf = (LAS float*)(F.lds + RING_BYTES) + F.wave * 64; LAS float* XO = (LAS float*)F.lds;
    const bf16* Qb = (const bf16*)(F.ws + WS_R + R_Q); const bf16* Kb = (const bf16*)(F.ws + WS_R + R_K); const bf16* VT = (const bf16*)(F.ws + WS_R + R_VT);
    int lane = F.lane; asm volatile("" : "+v"(lane)); const int wid = F.wave, wq = wid & 3; constexpr int j = J;     const int r32 = lane & 31, hi = lane >> 5;
    const int q0 = qb * 128, qw0 = q0 + wq * 32; const size_t rowbase = (size_t)b * 2048;
    const int NS = 4 * (qb + 1);
    bf16x8 qf[8];
    { const bf16* qp = (Qb + (rowbase + qw0) * 2048 + h * 256 + j * 128) + (unsigned)(r32 * 2048 + hi * 8);
#pragma unroll
      for (int ks = 0; ks < 8; ++ks) qf[ks] = *(const bf16x8*)(qp + ks * 16); }
    attn_dma(ring, 0, 0, wid, lane, Kb, VT, rowbase, b, h);
    attn_dma(ring, 1, 1, wid, lane, Kb, VT, rowbase, b, h);
    f32x16 o[8];
#pragma unroll
    for (int dt = 0; dt < 8; ++dt)
#pragma unroll
        for (int r = 0; r < 16; ++r) o[dt][r] = 0.f;
    float mrow = -1e30f, lrow = 0.f;
    for (int s0 = 0; s0 < NS; s0 += 2) {
        asm volatile("s_waitcnt vmcnt(0)" ::: "memory"); __syncthreads();
        if (s0 + 2 < NS) { attn_dma(ring, (s0 + 2) & 3, s0 + 2, wid, lane, Kb, VT, rowbase, b, h); attn_dma(ring, (s0 + 3) & 3, s0 + 3, wid, lane, Kb, VT, rowbase, b, h); }
        if constexpr (J == 0) {
#pragma unroll 1
            for (int s = s0; s < s0 + 2; ++s) {
                const int kvh = 32 * s;
                if (kvh > qw0 + 31) break;
            const LAS unsigned char* stg = ring + (s & 3) * 32768;
            f32x16 p;
    #pragma unroll
            for (int r = 0; r < 16; ++r) p[r] = 0.f;
            { const LAS unsigned char* kb = stg + j * 8192 + r32 * 256; bf16x8 kf[4];
    #pragma unroll
              for (int ks = 0; ks < 4; ++ks) kf[ks] = *(const LAS bf16x8*)(kb + (((2 * ks + hi) ^ (r32 & 15)) * 16));
              __builtin_amdgcn_sched_barrier(0);
    #pragma unroll
              for (int ks = 0; ks < 4; ++ks) { p = MFMA32(kf[ks], qf[ks], p); kf[ks] = *(const LAS bf16x8*)(kb + (((2 * (ks + 4) + hi) ^ (r32 & 15)) * 16)); }
              __builtin_amdgcn_sched_barrier(0);
    #pragma unroll
              for (int ks = 0; ks < 4; ++ks) p = MFMA32(kf[ks], qf[ks + 4], p); }
            const LAS unsigned char* vb = stg + 16384 + r32 * 64;
            const int g4 = (r32 >> 2) & 3; const int c0 = (hi ^ g4) * 16, c1 = ((2 + hi) ^ g4) * 16;
            if (kvh + 31 > qw0) {
    #pragma unroll
                for (int r = 0; r < 16; ++r) if (kvh + crow(r, hi) > qw0 + r32) p[r] = -INFINITY;
            }
            float mx = p[0];
    #pragma unroll
            for (int r = 1; r < 16; ++r) mx = fmaxf(mx, p[r]);
            { auto rr = __builtin_amdgcn_permlane32_swap(__float_as_uint(mx), __float_as_uint(mx), false, false); mx = fmaxf(__uint_as_float(rr[0]), __uint_as_float(rr[1])); }
            if (__any(mx > mrow + 8.f)) {
                const float mnew = fmaxf(mrow, mx);
                const float f = __builtin_amdgcn_exp2f(mrow - mnew); lrow *= f; mrow = mnew;
                if (hi == 0) wsf[r32] = f;
                asm volatile("s_waitcnt lgkmcnt(0)" ::: "memory");
    #pragma unroll
                for (int r4 = 0; r4 < 4; ++r4) { const f32x4 f4 = *(const LAS f32x4*)(wsf + 8 * r4 + 4 * hi);
    #pragma unroll
                    for (int dt = 0; dt < 8; ++dt)
    #pragma unroll
                        for (int e = 0; e < 4; ++e) o[dt][4 * r4 + e] *= f4[e]; }
            }
            bf16x8 va[4];
            va[0] = *(const LAS bf16x8*)(vb + c0); va[1] = *(const LAS bf16x8*)(vb + c1);
            __builtin_amdgcn_sched_barrier(0);
            float ls = 0.f;
    #pragma unroll
            for (int r = 0; r < 16; ++r) { p[r] = __builtin_amdgcn_exp2f(p[r] - mrow); ls += p[r]; }
            lrow += ls;
            v4u pw0, pw1;
            pw0.x = pk2(p[0], p[1]); pw0.y = pk2(p[2], p[3]); pw0.z = pk2(p[4], p[5]); pw0.w = pk2(p[6], p[7]);
            pw1.x = pk2(p[8], p[9]); pw1.y = pk2(p[10], p[11]); pw1.z = pk2(p[12], p[13]); pw1.w = pk2(p[14], p[15]);
            const bf16x8 pa0 = __builtin_bit_cast(bf16x8, pw0), pa1 = __builtin_bit_cast(bf16x8, pw1);
            va[2] = *(const LAS bf16x8*)(vb + 2048 + c0); va[3] = *(const LAS bf16x8*)(vb + 2048 + c1);
            __builtin_amdgcn_sched_barrier(0);
    #pragma unroll
            for (int dt = 0; dt < 8; ++dt) { const int k2 = (dt & 1) * 2;
                o[dt] = MFMA32(pa0, va[k2], o[dt]); o[dt] = MFMA32(pa1, va[k2 + 1], o[dt]);
                if (dt + 2 < 8) { va[k2] = *(const LAS bf16x8*)(vb + (dt + 2) * 2048 + c0); va[k2 + 1] = *(const LAS bf16x8*)(vb + (dt + 2) * 2048 + c1); }
                __builtin_amdgcn_sched_barrier(0);
            }
            }
        } else {
            const int s = s0;
            const int kvh = 32 * s;
            if (kvh > qw0 + 31) continue;
            const bool two = (kvh + 32 <= qw0 + 31);
            const LAS unsigned char* stg0 = ring + (s & 3) * 32768; const LAS unsigned char* stg1 = ring + ((s + 1) & 3) * 32768;
            f32x16 p0, p1;
    #pragma unroll
            for (int r = 0; r < 16; ++r) { p0[r] = 0.f; p1[r] = 0.f; }
            { const LAS unsigned char* kb0 = stg0 + j * 8192 + r32 * 256; const LAS unsigned char* kb1 = stg1 + j * 8192 + r32 * 256;
              __builtin_amdgcn_s_setprio(1);
              int zk = (hi ^ (r32 & 15)) * 16; asm volatile("" : "+v"(zk));
    #pragma unroll
              for (int ks = 0; ks < 8; ++ks) { const int co = zk ^ (32 * ks);
                  const bf16x8 k0 = *(const LAS bf16x8*)(kb0 + co); const bf16x8 k1 = *(const LAS bf16x8*)(kb1 + co);
                  p0 = MFMA32(k0, qf[ks], p0); p1 = MFMA32(k1, qf[ks], p1);
                  __builtin_amdgcn_sched_barrier(0); }
              __builtin_amdgcn_s_setprio(0); }
            if (kvh + 63 > qw0) {
    #pragma unroll
                for (int r = 0; r < 16; ++r) { if (kvh + crow(r, hi) > qw0 + r32) p0[r] = -INFINITY; if (kvh + 32 + crow(r, hi) > qw0 + r32) p1[r] = -INFINITY; }
            }
            float mx = fmaxf(p0[0], p1[0]);
    #pragma unroll
            for (int r = 1; r < 16; ++r) mx = fmaxf(fmaxf(mx, p0[r]), p1[r]);
            { auto rr = __builtin_amdgcn_permlane32_swap(__float_as_uint(mx), __float_as_uint(mx), false, false); mx = fmaxf(__uint_as_float(rr[0]), __uint_as_float(rr[1])); }
            if (__any(mx > mrow + 8.f)) {
                const float mnew = fmaxf(mrow, mx);
                const float f = __builtin_amdgcn_exp2f(mrow - mnew); lrow *= f; mrow = mnew;
                if (hi == 0) wsf[r32] = f;
                asm volatile("s_waitcnt lgkmcnt(0)" ::: "memory");
    #pragma unroll
                for (int r4 = 0; r4 < 4; ++r4) { const f32x4 f4 = *(const LAS f32x4*)(wsf + 8 * r4 + 4 * hi);
    #pragma unroll
                    for (int dt = 0; dt < 8; ++dt)
    #pragma unroll
                        for (int e = 0; e < 4; ++e) o[dt][4 * r4 + e] *= f4[e]; }
            }
            float ls = 0.f;
    #pragma unroll
            for (int r = 0; r < 16; ++r) { p0[r] = __builtin_amdgcn_exp2f(p0[r] - mrow); p1[r] = __builtin_amdgcn_exp2f(p1[r] - mrow); ls += p0[r] + p1[r]; }
            lrow += ls;
            v4u pw0, pw1, pw2, pw3;
            pw0.x = pk2(p0[0], p0[1]); pw0.y = pk2(p0[2], p0[3]); pw0.z = pk2(p0[4], p0[5]); pw0.w = pk2(p0[6], p0[7]);
            pw1.x = pk2(p0[8], p0[9]); pw1.y = pk2(p0[10], p0[11]); pw1.z = pk2(p0[12], p0[13]); pw1.w = pk2(p0[14], p0[15]);
            pw2.x = pk2(p1[0], p1[1]); pw2.y = pk2(p1[2], p1[3]); pw2.z = pk2(p1[4], p1[5]); pw2.w = pk2(p1[6], p1[7]);
            pw3.x = pk2(p1[8], p1[9]); pw3.y = pk2(p1[10], p1[11]); pw3.z = pk2(p1[12], p1[13]); pw3.w = pk2(p1[14], p1[15]);
            const bf16x8 pa0 = __builtin_bit_cast(bf16x8, pw0), pa1 = __builtin_bit_cast(bf16x8, pw1), pa2 = __builtin_bit_cast(bf16x8, pw2), pa3 = __builtin_bit_cast(bf16x8, pw3);
            const LAS unsigned char* vb0 = stg0 + 16384 + r32 * 64; const LAS unsigned char* vb1 = stg1 + 16384 + r32 * 64;
            const int g4 = (r32 >> 2) & 3; const int c0 = (hi ^ g4) * 16, c1 = ((2 + hi) ^ g4) * 16;
            __builtin_amdgcn_sched_barrier(0);
            __builtin_amdgcn_s_setprio(1);
    #pragma unroll
            for (int dt = 0; dt < 8; ++dt) {
                const bf16x8 v0 = *(const LAS bf16x8*)(vb0 + dt * 2048 + c0), v1 = *(const LAS bf16x8*)(vb0 + dt * 2048 + c1);
                o[dt] = MFMA32(pa0, v0, o[dt]); o[dt] = MFMA32(pa1, v1, o[dt]);
                __builtin_amdgcn_sched_barrier(0);
                { const bf16x8 v2 = *(const LAS bf16x8*)(vb1 + dt * 2048 + c0), v3 = *(const LAS bf16x8*)(vb1 + dt * 2048 + c1);
                    o[dt] = MFMA32(pa2, v2, o[dt]); o[dt] = MFMA32(pa3, v3, o[dt]); }
                __builtin_amdgcn_sched_barrier(0);
            }
            __builtin_amdgcn_s_setprio(0);
        }
    }
    int le_ = F.tid & 63; asm volatile("" : "+v"(le_)); const int r32e = le_ & 31, hie = le_ >> 5;
    { auto rr = __builtin_amdgcn_permlane32_swap(__float_as_uint(lrow), __float_as_uint(lrow), false, false); lrow = __uint_as_float(rr[0]) + __uint_as_float(rr[1]); }
    { const float linv = (j == 1 ? lam : 1.f) / lrow;
      if (hie == 0) wsf[r32e] = linv; }
    asm volatile("s_waitcnt lgkmcnt(0)" ::: "memory");
#pragma unroll
    for (int r4 = 0; r4 < 4; ++r4) { const f32x4 f4 = *(const LAS f32x4*)(wsf + 8 * r4 + 4 * hie);
#pragma unroll
        for (int dt = 0; dt < 8; ++dt)
#pragma unroll
            for (int e = 0; e < 4; ++e) o[dt][4 * r4 + e] *= f4[e]; }
    __syncthreads();
    if (j == 1) {
#pragma unroll
        for (int dt = 0; dt < 8; ++dt)
#pragma unroll
            for (int r = 0; r < 16; ++r) XO[(wq * 32 + crow(r, hie)) * 256 + 32 * dt + r32e] = o[dt][r];
    }
    __syncthreads();
    if (j == 0) {
#pragma unroll
        for (int dt = 0; dt < 8; ++dt) {
#pragma unroll
            for (int r = 0; r < 16; ++r) { LAS float* xp = XO + (wq * 32 + crow(r, hie)) * 256 + 32 * dt + r32e; *xp = o[dt][r] - *xp; }
            __builtin_amdgcn_sched_barrier(0); }
        asm volatile("s_waitcnt lgkmcnt(0)" ::: "memory");
        int l3 = lane; asm volatile("" : "+v"(l3));
        bf16* op = (Ob + (rowbase + qw0) * 2048 + h * 256) + (unsigned)((l3 >> 5) * 2048 + (l3 & 31) * 8);
        const LAS float* ip = XO + (wq * 32 + (l3 >> 5)) * 256 + (l3 & 31) * 8;
#pragma unroll 4
        for (int it = 0; it < 16; ++it) {
            const f32x4 a = *(const LAS f32x4*)(ip + it * 512), c = *(const LAS f32x4*)(ip + it * 512 + 4);
            float ss = (a[0] * a[0] + a[1] * a[1]) + (a[2] * a[2] + a[3] * a[3]) + (c[0] * c[0] + c[1] * c[1]) + (c[2] * c[2] + c[3] * c[3]);
#pragma unroll
            for (int sh = 1; sh < 32; sh <<= 1) ss += __shfl_xor(ss, sh);
            const float rn = rsqrtf(ss * (1.f / 256.f) + EPS);
            v4u w; w.x = pk2(a[0] * rn, a[1] * rn); w.y = pk2(a[2] * rn, a[3] * rn); w.z = pk2(c[0] * rn, c[1] * rn); w.w = pk2(c[2] * rn, c[3] * rn);
            *(v4u*)(op + (size_t)it * 4096) = w;
        }
    }
    __syncthreads();
}

#define XB_TMO      128
#define XB_XCNT(j)  (256  + 64 * (j))
#define XB_XSUB(j)  (1280 + 64 * (j))
#define XB_XGEN(j)  (2304 + 64 * (j))
#define XB_TOP      3328
#define XB_TOPGEN   3392
#define XCD_BAR_WORDS 3456
#define XB_SPIN_CAP (1u << 18)

__device__ __forceinline__ unsigned xb_ld(unsigned* p)              { return __hip_atomic_load(p, __ATOMIC_RELAXED, __HIP_MEMORY_SCOPE_AGENT); }
__device__ __forceinline__ unsigned xb_add(unsigned* p, unsigned v) { return __hip_atomic_fetch_add(p, v, __ATOMIC_RELAXED, __HIP_MEMORY_SCOPE_AGENT); }
__device__ __forceinline__ unsigned xb_xcc_id() { return (unsigned)__builtin_amdgcn_s_getreg((3 << 11) | 20) & 0xFu; }
#define XB_SPIN(cond, bar) do { unsigned _sp = 0; while (cond) { __builtin_amdgcn_s_sleep(1); \
    if ((++_sp & 255u) == 0u) { if (xb_ld(&(bar)[XB_TMO])) break; if (_sp > XB_SPIN_CAP) { atomicAdd(&(bar)[XB_TMO], 1u); break; } } } } while (0)

struct XcdBarrier {
    unsigned* bar; unsigned x;
    volatile LAS unsigned* st;
};

__device__ __forceinline__ XcdBarrier xcd_barrier_post(unsigned* bar, volatile LAS unsigned* st) {
    XcdBarrier b; b.bar = bar; b.x = xb_xcc_id(); b.st = st;
    if (threadIdx.x == 0) (void)xb_add(&bar[XB_XCNT(b.x)], 1u);
    return b;
}
__device__ __forceinline__ void xcd_barrier_complete(unsigned* bar, unsigned x, unsigned& nloc, unsigned& nx) {
    const unsigned G = gridDim.x * gridDim.y * gridDim.z;
    unsigned sum, cnt, mine, sp = 0u;
    for (;;) {
        sum = 0u; cnt = 0u; mine = 0u;
#pragma unroll
        for (unsigned j = 0; j < 16; ++j) { const unsigned c = xb_ld(&bar[XB_XCNT(j)]); sum += c; cnt += (c > 0u) ? 1u : 0u; mine = (j == x) ? c : mine; }
        if (sum == G) break;
        __builtin_amdgcn_s_sleep(1);
        if ((++sp & 255u) == 0u) { if (xb_ld(&bar[XB_TMO])) break; if (sp > XB_SPIN_CAP) { atomicAdd(&bar[XB_TMO], 1u); break; } }
    }
    nloc = mine > 0u ? mine : 1u; nx = cnt > 0u ? cnt : 1u;
}

__device__ __forceinline__ void xcd_barrier(const XcdBarrier& b) {
    asm volatile("s_waitcnt vmcnt(0)" ::: "memory");
    __syncthreads();
    if (threadIdx.x == 0) {
        unsigned* bar = b.bar;
        __builtin_amdgcn_s_waitcnt(0);
        unsigned nloc = b.st[0], nx = b.st[1];
        if (nloc == 0u) { xcd_barrier_complete(bar, b.x, nloc, nx); b.st[0] = nloc; b.st[1] = nx; }
        const unsigned old = xb_add(&bar[XB_XSUB(b.x)], 1u);
        const unsigned gen = old / nloc;
        if (old + 1u == (gen + 1u) * nloc) {
            __builtin_amdgcn_fence(__ATOMIC_RELEASE, "agent");
            asm volatile("s_waitcnt vmcnt(0)" ::: "memory");
            const unsigned og = xb_add(&bar[XB_TOP], 1u);
            const unsigned tg = og / nx;
            if (og + 1u == (tg + 1u) * nx) xb_add(&bar[XB_TOPGEN], 1u);
            else XB_SPIN(xb_ld(&bar[XB_TOPGEN]) == tg, bar);
            __builtin_amdgcn_fence(__ATOMIC_ACQUIRE, "agent");
            xb_add(&bar[XB_XGEN(b.x)], 1u);
            asm volatile("s_waitcnt vmcnt(0)" ::: "memory");
        } else {
            XB_SPIN(xb_ld(&bar[XB_XGEN(b.x)]) == gen, bar);
            __builtin_amdgcn_fence(__ATOMIC_ACQUIRE, "agent");
            asm volatile("s_waitcnt vmcnt(0)" ::: "memory");
        }
    }
    __syncthreads();
}

__global__ void __launch_bounds__(512, 2) mega_fwd(Args args) {
    extern __shared__ __attribute__((aligned(16))) unsigned char lds[];
    cg::grid_group grid = cg::this_grid();
    Frame F;
    F.lds = (LAS unsigned char*)lds;
    F.tid = threadIdx.x; F.lane = F.tid & 63; F.wave = __builtin_amdgcn_readfirstlane(F.tid >> 6);
    F.G = gridDim.x; { const int bx = blockIdx.x; F.vcu = (F.G % 8 == 0) ? (bx % 8) * (F.G / 8) + bx / 8 : bx; }
    F.out = args.out; F.ws = args.ws;
    unsigned char* ws = args.ws;
    volatile LAS unsigned* MISC = (volatile LAS unsigned*)(F.lds + RING_BYTES + 3072);
    if (F.tid < 16) MISC[F.tid] = 0u;
    __syncthreads();
    XcdBarrier bar = xcd_barrier_post((unsigned*)(ws + WS_SMALL), MISC + 8);
    const int lo = args.ph_lo, hi = args.ph_hi;
#ifndef PH_MASK
#define PH_MASK 0x7fff
#endif
#define IN(k) (((PH_MASK >> (k)) & 1) && lo <= (k) && (k) < hi)
#define SEAM(k) do { if (IN(k) && IN((k) + 1)) { xcd_barrier(bar); } } while (0)
    bf16* XN = (bf16*)(ws + WS_XN); float* rsp = (float*)(ws + WS_SMALL + S_RSP); float* rstd = (float*)(ws + WS_SMALL + S_RSTD);
    bf16* FF0 = (bf16*)F.out; bf16* FF1 = (bf16*)(ws + WS_WIN);
    typedef pg8::StaticOrder SO;

    if (args.ph_lo < 0) grid.sync();
    if (IN(0)) { p0_prologue(F, args); } SEAM(0);
    if (IN(1)) { pg8::Gemm g{XN, (const bf16*)(ws + WS_WIN), M, D, D}; SO S; S.init(M, D, F.G, (int)blockIdx.x);
        pg8::EpiStore<0, false, true> E{(bf16*)(ws + WS_R + R_U), D, nullptr, rstd};
        pg8::gemm_phase<pg8::EpiStore<0, false, true>, SO, true, true>(F.lds, g, S, E); } SEAM(1);
    if (IN(2)) { for (int u = F.vcu; u < NG * 8; u += F.G) s5_unit(F, args.in[13], u & 7, u >> 3); } SEAM(2);
    if (IN(3)) { pg8::Gemm g{(const bf16*)(ws + WS_R + R_Z), (const bf16*)(ws + WS_WGLU), M, 2 * D, D}; SO S; S.init(M, 2 * D, F.G, (int)blockIdx.x);
        pg8::EpiGlu E{(bf16*)(ws + WS_R + R_MIX), rsp};
        pg8::gemm_phase<pg8::EpiGlu, SO, true, true>(F.lds, g, S, E); } SEAM(3);
    if (IN(4)) { rowpass<true>(F, args.in[0], (const bf16*)(ws + WS_R + R_MIX), rsp, 64, args.in[2], XN, rstd, nullptr); } SEAM(4);
#if STOP_STAGE != 1
    if (IN(5)) { pg8::Gemm g{XN, (const bf16*)(ws + WS_WUP0), M, FF, D}; SO S; S.init(M, FF, F.G, (int)blockIdx.x);
        pg8::EpiStore<1, false, true> E{(bf16*)(ws + WS_R), FF, nullptr, rstd};
        pg8::gemm_phase<pg8::EpiStore<1, false, true>, SO, true, true>(F.lds, g, S, E); } SEAM(5);
    if (IN(6)) { pg8::Gemm g{(const bf16*)(ws + WS_R), (const bf16*)(ws + WS_WDN0), M, D, FF}; SO S; S.init(M, D, F.G, (int)blockIdx.x);
        pg8::EpiStore<0, true> E{FF0, D, rsp, nullptr};
        pg8::gemm_phase<pg8::EpiStore<0, true>, SO, true, true>(F.lds, g, S, E); } SEAM(6);
    if (IN(7)) { rowpass<false>(F, XN, FF0, rsp, 32, args.in[4], XN, rstd, nullptr); } SEAM(7);
#if STOP_STAGE != 2
    if (IN(8)) { pg8::Gemm g{XN, (const bf16*)(ws + WS_WQKV), M, 3 * D, D}; SO S; S.init(M, 3 * D, F.G, (int)blockIdx.x);
        const float* cosT = (const float*)(ws + WS_SMALL + S_ROPE);
        pg8::EpiQKV E{(bf16*)(ws + WS_R + R_K), (bf16*)(ws + WS_R + R_VT), (bf16*)(ws + WS_R + R_Q), cosT, cosT + 2048 * 64, 0.08838834764831845f * 1.4426950408889634f, rstd};
        pg8::gemm_phase<pg8::EpiQKV, SO, true, true>(F.lds, g, S, E); } SEAM(8);
    if (IN(9)) {
        float lam;
        { const float a = args.in[18][F.lane] * args.in[19][F.lane] + args.in[18][F.lane + 64] * args.in[19][F.lane + 64];
          const float c = args.in[20][F.lane] * args.in[21][F.lane] + args.in[20][F.lane + 64] * args.in[21][F.lane + 64];
          lam = expf(wave_sum(a)) - expf(wave_sum(c)) + (0.8f - 0.6f * expf(-0.3f)); lam = __builtin_bit_cast(float, __builtin_amdgcn_readfirstlane(__builtin_bit_cast(int, lam))); }
        const int bh = F.vcu >> 2, s = F.vcu & 3; bf16* Odst = (bf16*)(ws + WS_R + R_O);
#pragma unroll 1
        for (int u = F.vcu; u < 1024; u += F.G) { const int i = u >> 8, v = u & 255, bh2 = v >> 2, sq = v & 3;
            const int qb = (i == 0) ? 15 - sq : (i == 1) ? 8 + sq : (i == 2) ? 7 - sq : sq; if (F.wave < 4) attn_unit<0>(F, bh2 >> 3, bh2 & 7, qb, lam, Odst); else attn_unit<1>(F, bh2 >> 3, bh2 & 7, qb, lam, Odst); }
    } SEAM(9);
    if (IN(10)) { pg8::Gemm g{(const bf16*)(ws + WS_R + R_O), (const bf16*)(ws + WS_WO), M, D, D}; SO S; S.init(M, D, F.G, (int)blockIdx.x);
        pg8::EpiStore<0, true> E{(bf16*)(ws + WS_R + R_MIX1), D, rsp, nullptr};
        pg8::gemm_phase<pg8::EpiStore<0, true>, SO, true, true>(F.lds, g, S, E); } SEAM(10);
    if (IN(11)) { rowpass<false>(F, XN, (const bf16*)(ws + WS_R + R_MIX1), rsp, 32, args.in[2] + D, XN, rstd, nullptr); } SEAM(11);
#if STOP_STAGE != 3
    if (IN(12)) { pg8::Gemm g{XN, (const bf16*)(ws + WS_WUP1), M, FF, D}; SO S; S.init(M, FF, F.G, (int)blockIdx.x);
        pg8::EpiStore<1, false, true> E{(bf16*)(ws + WS_R), FF, nullptr, rstd};
        pg8::gemm_phase<pg8::EpiStore<1, false, true>, SO, true, true>(F.lds, g, S, E); } SEAM(12);
    if (IN(13)) { pg8::Gemm g{(const bf16*)(ws + WS_R), (const bf16*)(ws + WS_WDN1), M, D, FF}; SO S; S.init(M, D, F.G, (int)blockIdx.x);
        pg8::EpiStore<0, true> E{FF1, D, rsp, nullptr};
        pg8::gemm_phase<pg8::EpiStore<0, true>, SO, true, true>(F.lds, g, S, E); } SEAM(13);
    if (IN(14)) { rowpass<false>(F, XN, FF1, rsp, 32, args.in[4] + D, nullptr, nullptr, F.out); }
#endif
#endif
#endif
#undef IN
#undef SEAM
}

extern "C" void kernel_launch(void* const* d_in, const int* in_sizes, int n_in, void* d_out, int out_size, void* d_ws, size_t ws_size, hipStream_t stream) {
    static int grid = 0;
    if (grid == 0) {
        if (n_in != 26 || out_size != M * D || ws_size < WS_END) { fprintf(stderr, "kernel_launch: unexpected shapes (n_in %d, out %d, ws %zu)\n", n_in, out_size, ws_size); grid = -1; return; }
        int dev = 0, cus = 0, per_cu = 0;
        hipGetDevice(&dev); hipDeviceGetAttribute(&cus, hipDeviceAttributeMultiprocessorCount, dev);
        hipFuncSetAttribute((const void*)mega_fwd, hipFuncAttributeMaxDynamicSharedMemorySize, LDS_BYTES);
        hipOccupancyMaxActiveBlocksPerMultiprocessor(&per_cu, (const void*)mega_fwd, 512, LDS_BYTES);
        (void)hipGetLastError();
        if (per_cu < 1) per_cu = 1;
        grid = cus;
    }
    if (grid < 0) return;
    Args a{};
    for (int i = 0; i < 26; ++i) a.in[i] = (const float*)d_in[i];
    a.out = (float*)d_out; a.ws = (unsigned char*)d_ws;
#ifndef LAUNCH_RANGES
#define LAUNCH_RANGES {0, 15}
#endif
    static const int ranges[][2] = {LAUNCH_RANGES};
    hipError_t e = hipSuccess;
    for (unsigned li = 0; li < sizeof(ranges) / sizeof(ranges[0]) && e == hipSuccess; ++li) {
        if (hipMemsetAsync((char*)d_ws + WS_SMALL, 0, 16384, stream) != hipSuccess) { fprintf(stderr, "kernel_launch: memset failed\n"); return; }
        a.ph_lo = ranges[li][0]; a.ph_hi = ranges[li][1];
        void* kargs[] = {&a};
        e = hipLaunchCooperativeKernel((const void*)mega_fwd, dim3(grid), dim3(512), kargs, LDS_BYTES, stream);
    }
    if (e != hipSuccess) fprintf(stderr, "cooperative launch failed: %s (grid %d)\n", hipGetErrorString(e), grid);
}
```
